# Optimizing an MI355X kernel written in HIP

```python
import math
import jax, jax.numpy as jnp
from jax import lax
import numpy as np

D_MODEL = 1024
BATCH = 4
SEQ = 4096
DEPTH = 1
DEC_BATCH = 128
DEC_SEQ = 4
PAST_LEN = 8192
PAGE_SIZE = 128

HEAD_DIM = 64
A_Q_HEADS = 8
A_KV_HEADS = 2
A_GROUP = A_Q_HEADS // A_KV_HEADS
A_WINDOW = 128
A_DILATION = 1
B_GROUPS = ((128, 1), (512, 4), (2048, 16))
N_B_GROUPS = 3
B_HEADS = 8
A_WIDTH = A_Q_HEADS * HEAD_DIM
A_KV_WIDTH = A_KV_HEADS * HEAD_DIM
B_WIDTH = B_HEADS * HEAD_DIM
B_QKV_WIDTH = N_B_GROUPS * B_HEADS * HEAD_DIM
H_TOTAL = A_Q_HEADS + N_B_GROUPS * B_HEADS
N_BUCKETS = 32
MAX_DISTANCE = 2048
EPS = 1e-6
NEG_INF = -1e30
Q_SCALE = HEAD_DIM ** -0.5
IN_SPLITS = (A_WIDTH, A_KV_WIDTH, A_KV_WIDTH, A_WIDTH, B_QKV_WIDTH, B_QKV_WIDTH, B_QKV_WIDTH, B_WIDTH, D_MODEL, D_MODEL)
C_IN = A_WIDTH + 2 * A_KV_WIDTH + A_WIDTH + 3 * B_QKV_WIDTH + B_WIDTH + 2 * D_MODEL

kernel_name = "hybrid_swa_sink_dilated_gated_merge_step"


def rmsnorm(x, g):
    x32 = x.astype(jnp.float32)
    y = x32 * lax.rsqrt(jnp.mean(x32 * x32, axis=-1, keepdims=True) + EPS)
    return (y * g.astype(jnp.float32)).astype(x.dtype)


def qk_norm(a, g, scale=1.0):
    a32 = a.astype(jnp.float32)
    y = a32 * lax.rsqrt(jnp.mean(a32 * a32, axis=-1, keepdims=True) + EPS)
    return (y * g.astype(jnp.float32) * scale).astype(a.dtype)


def t5_bucket(dist):
    max_exact = N_BUCKETS // 2
    d = jnp.maximum(dist, 0)
    df = jnp.maximum(d, 1).astype(jnp.float32)
    large = max_exact + (jnp.log(df / max_exact) / math.log(MAX_DISTANCE / max_exact)
                         * (N_BUCKETS - max_exact)).astype(jnp.int32)
    large = jnp.minimum(large, N_BUCKETS - 1)
    return jnp.where(d < max_exact, d, large)


def softmax_stats(s, mask, sink):
    s = jnp.where(mask, s, NEG_INF)
    m = jnp.max(s, axis=-1, keepdims=True)
    if sink is not None:
        m = jnp.maximum(m, sink)
    p = jnp.exp(s - m)
    l = jnp.sum(p, axis=-1, keepdims=True)
    if sink is not None:
        l = l + jnp.exp(sink - m)
    return p, l, m


def banded_window_attention(q, k, v, dilation, n_keys, bias_table, sink):
    N, S, Hk, G, Dh = q.shape
    d = dilation
    M = S // d
    blk = n_keys
    nb = -(-M // blk)
    Mp = nb * blk

    def to_blocks(a):
        a = a.reshape((N, M, d) + a.shape[2:])
        a = jnp.moveaxis(a, 2, 1).reshape((N * d, M) + a.shape[3:])
        a = jnp.pad(a, ((0, 0), (0, Mp - M)) + ((0, 0),) * (a.ndim - 2))
        return a.reshape((N * d, nb, blk) + a.shape[2:])

    def with_prev(a):
        prev = jnp.pad(a, ((0, 0), (1, 0)) + ((0, 0),) * (a.ndim - 2))[:, :-1]
        return jnp.concatenate([prev, a], axis=2)

    qb = to_blocks(q)
    kc = with_prev(to_blocks(k))
    vc = with_prev(to_blocks(v))
    s = jnp.einsum('nbqhgd,nbchd->nbhgqc', qb, kc, preferred_element_type=jnp.float32)
    qi = jnp.arange(blk)[:, None]
    ci = jnp.arange(2 * blk)[None, :]
    delta = qi + blk - ci
    band = (delta >= 0) & (delta < n_keys)
    key_pos = (jnp.arange(nb)[:, None, None] - 1) * blk + ci[None]
    mask = band[None] & (key_pos >= 0)
    bias = bias_table[t5_bucket(delta * d)]
    bias = jnp.transpose(bias, (2, 0, 1)).reshape(Hk, G, blk, 2 * blk).astype(jnp.float32)
    p, l, m = softmax_stats(s + bias, mask[None, :, None, None], sink)
    o = jnp.einsum('nbhgqc,nbchd->nbqhgd', p, vc.astype(jnp.float32))
    o = o / jnp.moveaxis(l[..., 0], -1, 2)[..., None]
    lse = jnp.moveaxis((m + jnp.log(l))[..., 0], -1, 2)

    def from_blocks(a):
        a = a.reshape((N * d, Mp) + a.shape[3:])[:, :M]
        a = a.reshape((N, d, M) + a.shape[2:])
        return jnp.moveaxis(a, 1, 2).reshape((N, S) + a.shape[3:])

    return from_blocks(o).astype(q.dtype), from_blocks(lse)


def gathered_window_attention(q, k_buf, v_buf, k_new, v_new, dilation, n_keys, bias_table, sink):
    N, T, Hk, G, Dh = q.shape
    L = k_buf.shape[1]
    k_all = jnp.concatenate([k_buf, k_new], axis=1)
    v_all = jnp.concatenate([v_buf, v_new], axis=1)
    idx = L + jnp.arange(T)[:, None] - jnp.arange(n_keys)[None, :] * dilation
    valid = idx >= 0
    flat = jnp.maximum(idx, 0).reshape(-1)
    kg = jnp.take(k_all, flat, axis=1).reshape(N, T, n_keys, Hk, Dh)
    vg = jnp.take(v_all, flat, axis=1).reshape(N, T, n_keys, Hk, Dh)
    s = jnp.einsum('nthgd,ntjhd->nhgtj', q, kg, preferred_element_type=jnp.float32)
    bias = bias_table[t5_bucket(jnp.arange(n_keys) * dilation)]
    bias = bias.T.reshape(Hk, G, 1, n_keys).astype(jnp.float32)
    p, l, m = softmax_stats(s + bias, valid, sink)
    o = jnp.einsum('nhgtj,ntjhd->nthgd', p, vg.astype(jnp.float32))
    o = o / jnp.transpose(l, (0, 3, 1, 2, 4))
    lse = jnp.transpose((m + jnp.log(l))[..., 0], (0, 3, 1, 2))
    return o.astype(q.dtype), lse


def mixer_inputs(x, norm_g, w_in, q_gain_a, k_gain_a, q_gain_b, k_gain_b):
    Bn, Sn = x.shape[:2]
    h = rmsnorm(x, norm_g)
    proj = jnp.einsum('bsd,dc->bsc', h, w_in)
    offsets = [int(o) for o in np.cumsum(IN_SPLITS)[:-1]]
    qa, ka, va, ga, qb, kb, vb, gb, ma, mb = jnp.split(proj, offsets, axis=-1)
    qa = qk_norm(qa.reshape(Bn, Sn, A_KV_HEADS, A_GROUP, HEAD_DIM), q_gain_a, Q_SCALE)
    ka = qk_norm(ka.reshape(Bn, Sn, A_KV_HEADS, HEAD_DIM), k_gain_a)
    va = va.reshape(Bn, Sn, A_KV_HEADS, HEAD_DIM)
    qb = qk_norm(qb.reshape(Bn, Sn, N_B_GROUPS, B_HEADS, HEAD_DIM), q_gain_b[:, None, :], Q_SCALE)
    kb = qk_norm(kb.reshape(Bn, Sn, N_B_GROUPS, B_HEADS, HEAD_DIM), k_gain_b[:, None, :])
    vb = vb.reshape(Bn, Sn, N_B_GROUPS, B_HEADS, HEAD_DIM)
    return qa, ka, va, ga, qb, kb, vb, gb, ma, mb


def combine_dilations(outs, lses):
    w = jax.nn.softmax(jnp.stack(lses, axis=0), axis=0)[..., None]
    o = jnp.sum(w * jnp.stack(outs, axis=0).astype(jnp.float32), axis=0)
    return o.astype(outs[0].dtype)


def mixer_output(x, o_a, o_b, ga, gb, ma, mb, w_up_a, w_up_b, w_out):
    Bn, Sn = x.shape[:2]
    ya = jnp.einsum('bsc,cd->bsd', o_a.reshape(Bn, Sn, A_WIDTH) * jax.nn.silu(ga), w_up_a)
    yb = jnp.einsum('bsc,cd->bsd', o_b.reshape(Bn, Sn, B_WIDTH) * jax.nn.silu(gb), w_up_b)
    merged = jax.nn.sigmoid(ma) * ya + jax.nn.sigmoid(mb) * yb
    return x + jnp.einsum('bsd,de->bse', merged, w_out)


def prompt_layer(x, rel_bias, norm_g, w_in, q_gain_a, k_gain_a, sinks_a, q_gain_b, k_gain_b, w_up_a, w_up_b, w_out):
    Sn = x.shape[1]
    qa, ka, va, ga, qb, kb, vb, gb, ma, mb = mixer_inputs(x, norm_g, w_in, q_gain_a, k_gain_a, q_gain_b, k_gain_b)
    sink = sinks_a.reshape(A_KV_HEADS, A_GROUP, 1, 1).astype(jnp.float32)
    o_a, _ = banded_window_attention(qa, ka, va, A_DILATION, A_WINDOW // A_DILATION,
                                     rel_bias[:, :A_Q_HEADS], sink)
    n_a = min(A_WINDOW, Sn)
    states = [jnp.stack([ka[:, Sn - n_a:], va[:, Sn - n_a:]], axis=2)]
    outs, lses = [], []
    for gi, (win, dil) in enumerate(B_GROUPS):
        c0 = A_Q_HEADS + gi * B_HEADS
        o, lse = banded_window_attention(qb[:, :, gi, :, None, :], kb[:, :, gi], vb[:, :, gi], dil, win // dil,
                                         rel_bias[:, c0:c0 + B_HEADS], None)
        outs.append(o)
        lses.append(lse)
        n_g = min(win, Sn)
        states.append(jnp.stack([kb[:, Sn - n_g:, gi], vb[:, Sn - n_g:, gi]], axis=2))
    o_b = combine_dilations(outs, lses)
    y = mixer_output(x, o_a, o_b, ga, gb, ma, mb, w_up_a, w_up_b, w_out)
    return y, states


def sample_layer(x, caches, rel_bias, norm_g, w_in, q_gain_a, k_gain_a, sinks_a, q_gain_b, k_gain_b, w_up_a, w_up_b, w_out):
    qa, ka, va, ga, qb, kb, vb, gb, ma, mb = mixer_inputs(x, norm_g, w_in, q_gain_a, k_gain_a, q_gain_b, k_gain_b)
    sink = sinks_a.reshape(A_KV_HEADS, A_GROUP, 1, 1).astype(jnp.float32)
    cache_a = caches[0]
    o_a, _ = gathered_window_attention(qa, cache_a[:, :, 0], cache_a[:, :, 1], ka, va, A_DILATION,
                                       A_WINDOW // A_DILATION, rel_bias[:, :A_Q_HEADS], sink)
    states = [jnp.stack([ka, va], axis=2)]
    outs, lses = [], []
    for gi, (win, dil) in enumerate(B_GROUPS):
        c0 = A_Q_HEADS + gi * B_HEADS
        cache_g = caches[1 + gi]
        o, lse = gathered_window_attention(qb[:, :, gi, :, None, :], cache_g[:, :, 0], cache_g[:, :, 1],
                                           kb[:, :, gi], vb[:, :, gi], dil, win // dil,
                                           rel_bias[:, c0:c0 + B_HEADS], None)
        outs.append(o)
        lses.append(lse)
        states.append(jnp.stack([kb[:, :, gi], vb[:, :, gi]], axis=2))
    o_b = combine_dilations(outs, lses)
    y = mixer_output(x, o_a, o_b, ga, gb, ma, mb, w_up_a, w_up_b, w_out)
    return y, states


def setup_inputs(seed: int = 0) -> dict:
    key = jax.random.key(seed)
    ks = jax.random.split(key, 20)
    f32 = jnp.float32
    la = min(A_WINDOW, PAST_LEN)
    l1 = min(B_GROUPS[0][0], PAST_LEN)
    l2 = min(B_GROUPS[1][0], PAST_LEN)
    l3 = min(B_GROUPS[2][0], PAST_LEN)
    return {
        "x_prompt": jax.random.normal(ks[0], (BATCH, SEQ, D_MODEL), f32),
        "x_sample": jax.random.normal(ks[1], (DEC_BATCH, DEC_SEQ, D_MODEL), f32),
        "cache_a_kv": jax.random.normal(ks[2], (DEPTH, DEC_BATCH, la, 2, A_KV_HEADS, HEAD_DIM), f32),
        "cache_b1_kv": jax.random.normal(ks[3], (DEPTH, DEC_BATCH, l1, 2, B_HEADS, HEAD_DIM), f32),
        "cache_b2_kv": jax.random.normal(ks[4], (DEPTH, DEC_BATCH, l2, 2, B_HEADS, HEAD_DIM), f32),
        "cache_b3_kv": jax.random.normal(ks[5], (DEPTH, DEC_BATCH, l3, 2, B_HEADS, HEAD_DIM), f32),
        "rel_bias": 0.5 * jax.random.normal(ks[6], (N_BUCKETS, H_TOTAL), f32),
        "norm_gain": 1.0 + 0.1 * jax.random.normal(ks[7], (DEPTH, D_MODEL), f32),
        "w_in": jax.random.normal(ks[8], (DEPTH, D_MODEL, C_IN), f32) * D_MODEL ** -0.5,
        "q_gain_a": 1.0 + 0.1 * jax.random.normal(ks[9], (DEPTH, HEAD_DIM), f32),
        "k_gain_a": 1.0 + 0.1 * jax.random.normal(ks[10], (DEPTH, HEAD_DIM), f32),
        "sinks_a": 0.5 * jax.random.normal(ks[11], (DEPTH, A_Q_HEADS), f32),
        "q_gain_b": 1.0 + 0.1 * jax.random.normal(ks[12], (DEPTH, N_B_GROUPS, HEAD_DIM), f32),
        "k_gain_b": 1.0 + 0.1 * jax.random.normal(ks[13], (DEPTH, N_B_GROUPS, HEAD_DIM), f32),
        "w_up_a": jax.random.normal(ks[14], (DEPTH, A_WIDTH, D_MODEL), f32) * A_WIDTH ** -0.5,
        "w_up_b": jax.random.normal(ks[15], (DEPTH, B_WIDTH, D_MODEL), f32) * B_WIDTH ** -0.5,
        "w_out": jax.random.normal(ks[16], (DEPTH, D_MODEL, D_MODEL), f32) * D_MODEL ** -0.5,
    }


def reference(x_prompt, x_sample, cache_a_kv, cache_b1_kv, cache_b2_kv, cache_b3_kv, rel_bias, norm_gain, w_in,
              q_gain_a, k_gain_a, sinks_a, q_gain_b, k_gain_b, w_up_a, w_up_b, w_out):
    yp = x_prompt
    ys = x_sample
    p_states = []
    s_states = []
    for layer in range(DEPTH):
        params = (norm_gain[layer], w_in[layer], q_gain_a[layer], k_gain_a[layer], sinks_a[layer],
                  q_gain_b[layer], k_gain_b[layer], w_up_a[layer], w_up_b[layer], w_out[layer])
        yp, ps = prompt_layer(yp, rel_bias, *params)
        caches = (cache_a_kv[layer], cache_b1_kv[layer], cache_b2_kv[layer], cache_b3_kv[layer])
        ys, ss = sample_layer(ys, caches, rel_bias, *params)
        p_states.append(ps)
        s_states.append(ss)
    new_prompt_a_kv = jnp.stack([st[0] for st in p_states])
    new_prompt_b1_kv = jnp.stack([st[1] for st in p_states])
    new_prompt_b2_kv = jnp.stack([st[2] for st in p_states])
    new_prompt_b3_kv = jnp.stack([st[3] for st in p_states])
    new_sample_a_kv = jnp.stack([st[0] for st in s_states])
    new_sample_b1_kv = jnp.stack([st[1] for st in s_states])
    new_sample_b2_kv = jnp.stack([st[2] for st in s_states])
    new_sample_b3_kv = jnp.stack([st[3] for st in s_states])
    return (yp, ys, new_prompt_a_kv, new_prompt_b1_kv, new_prompt_b2_kv, new_prompt_b3_kv,
            new_sample_a_kv, new_sample_b1_kv, new_sample_b2_kv, new_sample_b3_kv)
```

```cpp
#include <hip/hip_runtime.h>
#include <cstdio>
#include <cstdint>

#ifndef MK_N_LAUNCHES
#define MK_N_LAUNCHES 6
#endif

#define GAS __attribute__((address_space(1)))
#define LAS __attribute__((address_space(3)))
typedef unsigned short bf16;
typedef short bf16x8 __attribute__((ext_vector_type(8)));
typedef float f32x4 __attribute__((ext_vector_type(4)));
typedef float f32x2 __attribute__((ext_vector_type(2)));
typedef float f32x16 __attribute__((ext_vector_type(16)));
typedef unsigned u32x4 __attribute__((ext_vector_type(4)));
typedef unsigned u32x2 __attribute__((ext_vector_type(2)));
typedef short s16x4 __attribute__((ext_vector_type(4)));
typedef __bf16 bf16x2_t __attribute__((ext_vector_type(2)));

constexpr int DM = 1024, SEQ = 4096, NBATCH = 4, NP = NBATCH * SEQ, DECB = 128, DECT = 4, NSMP = DECB * DECT, MR = NP + NSMP, CIN = 8448;
constexpr int NWAVES = 8, NTHR = NWAVES * 64;
constexpr float LOG2E = 1.4426950408889634f;
constexpr float QSCALE = 0.125f * LOG2E;
constexpr float NEGBIG = -1.0e30f;
constexpr size_t OUT_YP = 0, OUT_YS = (size_t)NP * DM, OUT_PA = OUT_YS + (size_t)NSMP * DM, OUT_PB1 = OUT_PA + 4 * 128 * 2 * 2 * 64, OUT_PB2 = OUT_PB1 + 4 * 128 * 2 * 8 * 64,
                 OUT_PB3 = OUT_PB2 + 4 * 512 * 2 * 8 * 64, OUT_SA = OUT_PB3 + (size_t)4 * 2048 * 2 * 8 * 64, OUT_SB1 = OUT_SA + 128 * 4 * 2 * 2 * 64, OUT_SB2 = OUT_SB1 + 128 * 4 * 2 * 8 * 64,
                 OUT_SB3 = OUT_SB2 + 128 * 4 * 2 * 8 * 64, OUT_END = OUT_SB3 + 128 * 4 * 2 * 8 * 64;
static_assert(OUT_END == 30146560, "output size");
constexpr size_t MiB = 1u << 20;
constexpr size_t WS_CTL = 0, CTL_ZERO_BYTES = 1 * MiB;
constexpr size_t WS_WIN = 2 * MiB, WS_WUP = 20 * MiB, WS_WOUT = 22 * MiB, WS_HB = 32 * MiB, WS_Q = 72 * MiB, WS_KA = 140 * MiB, WS_VA = 146 * MiB, WS_KB = 152 * MiB, WS_VB = 204 * MiB,
                 WS_G = 256 * MiB, WS_OG = 360 * MiB, WS_LG = 412 * MiB, WS_AB = 416 * MiB, WS_T = 452 * MiB, WS_MG = 488 * MiB, WS_END = 528 * MiB;
constexpr int QP = 2048, KAP = 128, KBP = 1536, GP = 3072, OGP = 512;
constexpr int CW_BAR = 4096;
constexpr int RING_BYTES = 131072, LDSCTL_OFF = RING_BYTES, MISC_OFF = LDSCTL_OFF + 320, LDS_BYTES = 147456;
constexpr int AT_TAB = 0, AT_TAB_BYTES = 32 * 192 * 4, AT_VT = AT_TAB_BYTES, AT_LX = AT_VT + NWAVES * 4096, AT_RED = AT_LX + NWAVES * 128, AT_END = AT_RED + 256;
static_assert(AT_END <= RING_BYTES, "attention LDS");

#define LDS_WAIT() asm volatile("s_waitcnt lgkmcnt(0)" ::: "memory")
#define VM_WAIT() asm volatile("s_waitcnt vmcnt(0)" ::: "memory")
#define RLX_AGENT __ATOMIC_RELAXED, __HIP_MEMORY_SCOPE_AGENT
__device__ __forceinline__ unsigned cvtpk(float lo, float hi) { f32x2 v = {lo, hi}; bf16x2_t b = __builtin_convertvector(v, bf16x2_t); return __builtin_bit_cast(unsigned, b); }
__device__ __forceinline__ float bflo(unsigned w) { return __builtin_bit_cast(float, w << 16); }
__device__ __forceinline__ float bfhi(unsigned w) { return __builtin_bit_cast(float, w & 0xffff0000u); }
__device__ __forceinline__ float fexp2(float x) { return __builtin_amdgcn_exp2f(x); }

namespace pg8 {
constexpr int BM = 256, BK = 64, HALF = 128, HTB = HALF * BK * 2, STAGE_BYTES = 8 * HTB, NXCD = 8, WGM = 8;
__host__ __device__ __forceinline__ int lds_byte(int r, int c) { const int st = (r >> 4) * 2 + (c >> 5), rr = r & 15, cc = c & 31, ob = rr * 64 + cc * 2; return st * 1024 + (ob ^ (((ob >> 9) & 1) << 5)); }
__host__ __device__ __forceinline__ void stage_rc(int b, int& R, int& C) { const int st = b / 1024, sb = b % 1024, swz = sb ^ (((sb >> 9) & 1) << 5); R = (st >> 1) * 16 + swz / 64; C = (st & 1) * 32 + (swz % 64) / 2; }
__host__ __device__ __forceinline__ int perm32(int rho) { const int n = rho >> 4, i = rho & 15; return 8 * (i >> 2) + 4 * n + (i & 3); }
struct Unit { int pm, pn, kind; };
struct TileOrder {
    int nM, nN, nwg, G, c;
    __device__ void init(int M, int N, int G_, int c_) { nM = M / BM; nN = N / BM; nwg = nM * nN; G = G_; c = c_; }
    __device__ bool tile(int i, int& pm, int& pn) const {
        const long L = (long)i * G + c; if (L >= nwg) return false;
        int wgid = (int)L; { const int q = nwg / NXCD, r = nwg % NXCD, xcd = wgid % NXCD, off = wgid / NXCD; wgid = (xcd < r ? xcd * (q + 1) : r * (q + 1) + (xcd - r) * q) + off; }
        const int nig = WGM * nN, gid = wgid / nig, fm = gid * WGM, gsz = (nM - fm) < WGM ? (nM - fm) : WGM;
        pm = fm + ((wgid % nig) % gsz); pn = (wgid % nig) / gsz; return true;
    }
};

template <class Epi, class Sched, bool ALIGN_EPI, bool PERM>
__device__ __forceinline__ void gemm_phase(LAS unsigned char* lds, const int K, const int ldA, const int ldB, const Sched& S, const Epi& E) {
    const int tid = threadIdx.x, wid = __builtin_amdgcn_readfirstlane(tid >> 6), lane = tid & 63, wr = wid >> 2, wc = wid & 3, fr = lane & 15, fq = lane >> 4;
    const int nt = K / BK;
    unsigned voffA[2], voffB[2];
#pragma unroll
    for (int i = 0; i < 2; ++i) { int R, C; stage_rc(tid * 16 + i * 8192, R, C); const int Rb = PERM ? ((R & ~31) + perm32(R & 31)) : R;
        voffA[i] = (unsigned)(R * ldA + C) * 2u; voffB[i] = (unsigned)(Rb * ldB + C) * 2u; }
    const size_t kstep = (size_t)(BK * 2);
    const size_t hstepA = (size_t)HALF * ldA * 2, hstepB = (size_t)HALF * ldB * 2;
    const unsigned ldsw = (unsigned)wid * 1024u;
    const int aoff = lds_byte(wr * 64 + fr, fq * 8), boff = lds_byte(wc * 32 + fr, fq * 8);
#define PG8_SA(b, h) (((b) * 2 + (h)) * HTB)
#define PG8_SB(b, h) ((4 + (b) * 2 + (h)) * HTB)
#define PG8_STAGE(bufoff, gbase, voff) do { _Pragma("unroll") for (int _i = 0; _i < 2; ++_i) \
        __builtin_amdgcn_global_load_lds((const unsigned*)((const char*)(gbase) + (voff)[_i]), (LAS unsigned*)(lds + (bufoff) + ldsw + _i * 8192), 16, 0, 0); } while (0)
#define PG8_LDA(dst, b, h) do { _Pragma("unroll") for (int m = 0; m < 4; ++m) _Pragma("unroll") for (int k = 0; k < 2; ++k) dst[m][k] = *(const LAS bf16x8*)(lds + PG8_SA(b, h) + aoff + m * 2048 + k * 1024); } while (0)
#define PG8_LDB(dst, b, h) do { _Pragma("unroll") for (int n = 0; n < 2; ++n) _Pragma("unroll") for (int k = 0; k < 2; ++k) dst[n][k] = *(const LAS bf16x8*)(lds + PG8_SB(b, h) + boff + n * 2048 + k * 1024); } while (0)
#define PG8_MMA(ai, bj, At, Bt) do { __builtin_amdgcn_s_setprio(1); _Pragma("unroll") for (int m = 0; m < 4; ++m) _Pragma("unroll") for (int n = 0; n < 2; ++n) _Pragma("unroll") for (int k = 0; k < 2; ++k) \
        acc[ai][bj][m][n] = __builtin_amdgcn_mfma_f32_16x16x32_bf16(Bt[n][k], At[m][k], acc[ai][bj][m][n], 0, 0, 0); __builtin_amdgcn_s_setprio(0); } while (0)
#define PG8_WAIT_V(n) asm volatile("s_waitcnt vmcnt(" #n ")" ::: "memory")
#define PG8_WAIT_L(n) asm volatile("s_waitcnt lgkmcnt(" #n ")" ::: "memory")
#define PG8_BAR __builtin_amdgcn_s_barrier()
#define PG8_SCHED __builtin_amdgcn_sched_barrier(0)
    Unit cur, nxt; int ui = 0;
    if (!S.next(0, cur)) return;
    f32x4 acc[2][2][4][2];
#pragma unroll
    for (int a = 0; a < 2; ++a)
#pragma unroll
        for (int b = 0; b < 2; ++b)
#pragma unroll
            for (int m = 0; m < 4; ++m)
#pragma unroll
                for (int n = 0; n < 2; ++n) acc[a][b][m][n] = (f32x4){0.f, 0.f, 0.f, 0.f};
    bf16x8 At[4][2], B0[2][2], B1[2][2];
    const char* cA; const char* cB; S.ptrs(cur, cA, cB);
    PG8_STAGE(PG8_SB(0, 0), cB, voffB); PG8_STAGE(PG8_SB(0, 1), cB + hstepB, voffB); PG8_STAGE(PG8_SA(0, 0), cA, voffA); PG8_STAGE(PG8_SA(0, 1), cA + hstepA, voffA);
    if (wr == 1) PG8_BAR;
    PG8_WAIT_V(2); PG8_BAR;
    PG8_STAGE(PG8_SB(1, 0), cB + kstep, voffB); PG8_STAGE(PG8_SA(1, 0), cA + kstep, voffA); PG8_STAGE(PG8_SB(1, 1), cB + hstepB + kstep, voffB);
    PG8_WAIT_V(6); PG8_BAR;
    for (;;) {
        const bool has_next = S.next(ui + 1, nxt);
        const char* nA = cA; const char* nB = cB; if (has_next) S.ptrs(nxt, nA, nB);
        for (int t = 0; t < nt; t += 2) {
            const bool last = (t == nt - 2);
            const char* a1 = cA + (size_t)(t + 1) * kstep;
            const char* a2 = last ? nA : cA + (size_t)(t + 2) * kstep; const char* b2 = last ? nB : cB + (size_t)(t + 2) * kstep;
            const char* a3 = a2 + kstep; const char* b3 = b2 + kstep;
            PG8_LDB(B0, 0, 0); PG8_LDB(B1, 0, 1); PG8_SCHED; PG8_LDA(At, 0, 0); PG8_STAGE(PG8_SA(1, 1), a1 + hstepA, voffA);
            PG8_WAIT_V(8); PG8_WAIT_L(0); PG8_BAR; PG8_MMA(0, 0, At, B0); PG8_MMA(0, 1, At, B1); PG8_BAR; PG8_SCHED;
            PG8_LDA(At, 0, 1); PG8_STAGE(PG8_SB(0, 0), b2, voffB); PG8_STAGE(PG8_SB(0, 1), b2 + hstepB, voffB); PG8_STAGE(PG8_SA(0, 0), a2, voffA);
            PG8_WAIT_V(8); PG8_WAIT_L(0); PG8_BAR; PG8_MMA(1, 0, At, B0); PG8_MMA(1, 1, At, B1); PG8_BAR; PG8_SCHED;
            PG8_LDB(B0, 1, 0); PG8_LDB(B1, 1, 1); PG8_SCHED; PG8_LDA(At, 1, 0); PG8_STAGE(PG8_SA(0, 1), a2 + hstepA, voffA);
            PG8_WAIT_V(8); PG8_WAIT_L(0); PG8_BAR; PG8_MMA(0, 0, At, B0); PG8_MMA(0, 1, At, B1); PG8_BAR; PG8_SCHED;
            PG8_LDA(At, 1, 1); PG8_STAGE(PG8_SB(1, 0), b3, voffB); PG8_STAGE(PG8_SB(1, 1), b3 + hstepB, voffB); PG8_STAGE(PG8_SA(1, 0), a3, voffA);
            PG8_WAIT_V(8); PG8_WAIT_L(0); PG8_BAR; PG8_MMA(1, 0, At, B0); PG8_MMA(1, 1, At, B1); PG8_BAR; PG8_SCHED;
        }
        if constexpr (ALIGN_EPI) { if (wr == 0) PG8_BAR; }
        E(acc, cur, wr, wc, fr, fq);
        if (!has_next) break;
#pragma unroll
        for (int a = 0; a < 2; ++a)
#pragma unroll
            for (int b = 0; b < 2; ++b)
#pragma unroll
                for (int m = 0; m < 4; ++m)
#pragma unroll
                    for (int n = 0; n < 2; ++n) acc[a][b][m][n] = (f32x4){0.f, 0.f, 0.f, 0.f};
        cur = nxt; cA = nA; cB = nB; ++ui;
        if constexpr (ALIGN_EPI) { if (wr == 1) PG8_BAR; }
    }
    PG8_WAIT_V(0);
    if constexpr (!ALIGN_EPI) { if (wr == 0) PG8_BAR; }
    PG8_BAR;
#undef PG8_SA
#undef PG8_SB
#undef PG8_STAGE
#undef PG8_LDA
#undef PG8_LDB
#undef PG8_MMA
#undef PG8_WAIT_V
#undef PG8_WAIT_L
#undef PG8_BAR
#undef PG8_SCHED
}
}

#define XB_TMO      128
#define XB_XCNT(j)  (256  + 64 * (j))
#define XB_XSUB(j)  (1280 + 64 * (j))
#define XB_XGEN(j)  (2304 + 64 * (j))
#define XB_TOP      3328
#define XB_TOPGEN   3392
#define XCD_BAR_WORDS 3456
#define XB_SPIN_CAP (1u << 18)
__device__ __forceinline__ unsigned xb_ld(unsigned* p)              { return __hip_atomic_load(p, __ATOMIC_RELAXED, __HIP_MEMORY_SCOPE_AGENT); }
__device__ __forceinline__ unsigned xb_add(unsigned* p, unsigned v) { return __hip_atomic_fetch_add(p, v, __ATOMIC_RELAXED, __HIP_MEMORY_SCOPE_AGENT); }
__device__ __forceinline__ unsigned xb_xcc_id() { return (unsigned)__builtin_amdgcn_s_getreg((3 << 11) | 20) & 0xFu; }
#define XB_SPIN(cond, bar) do { unsigned _sp = 0; while (cond) { __builtin_amdgcn_s_sleep(1); \
    if ((++_sp & 255u) == 0u) { if (xb_ld(&(bar)[XB_TMO])) break; if (_sp > XB_SPIN_CAP) { atomicAdd(&(bar)[XB_TMO], 1u); break; } } } } while (0)
struct XcdBarrier { unsigned* bar; unsigned x; volatile LAS unsigned* st; };
__device__ __forceinline__ XcdBarrier xcd_barrier_post(unsigned* bar, volatile LAS unsigned* st) {
    XcdBarrier b; b.bar = bar; b.x = xb_xcc_id(); b.st = st;
    if (threadIdx.x == 0) (void)xb_add(&bar[XB_XCNT(b.x)], 1u);
    return b;
}
__device__ __forceinline__ void xcd_barrier_complete(unsigned* bar, unsigned x, unsigned& nloc, unsigned& nx) {
    const unsigned G = gridDim.x * gridDim.y * gridDim.z;
    unsigned sum, cnt, mine, sp = 0u;
    for (;;) {
        sum = 0u; cnt = 0u; mine = 0u;
#pragma unroll
        for (unsigned j = 0; j < 16; ++j) { const unsigned c = xb_ld(&bar[XB_XCNT(j)]); sum += c; cnt += (c > 0u) ? 1u : 0u; mine = (j == x) ? c : mine; }
        if (sum == G) break;
        __builtin_amdgcn_s_sleep(1);
        if ((++sp & 255u) == 0u) { if (xb_ld(&bar[XB_TMO])) break; if (sp > XB_SPIN_CAP) { atomicAdd(&bar[XB_TMO], 1u); break; } }
    }
    nloc = mine > 0u ? mine : 1u; nx = cnt > 0u ? cnt : 1u;
}
__device__ __forceinline__ void xcd_barrier(const XcdBarrier& b) {
    asm volatile("s_waitcnt vmcnt(0)" ::: "memory");
    __syncthreads();
    if (threadIdx.x == 0) {
        unsigned* bar = b.bar;
        __builtin_amdgcn_s_waitcnt(0);
        unsigned nloc = b.st[0], nx = b.st[1];
        if (nloc == 0u) { xcd_barrier_complete(bar, b.x, nloc, nx); b.st[0] = nloc; b.st[1] = nx; }
        const unsigned old = xb_add(&bar[XB_XSUB(b.x)], 1u);
        const unsigned gen = old / nloc;
        if (old + 1u == (gen + 1u) * nloc) {
            __builtin_amdgcn_fence(__ATOMIC_RELEASE, "agent");
            asm volatile("s_waitcnt vmcnt(0)" ::: "memory");
            const unsigned og = xb_add(&bar[XB_TOP], 1u);
            const unsigned tg = og / nx;
            if (og + 1u == (tg + 1u) * nx) xb_add(&bar[XB_TOPGEN], 1u);
            else XB_SPIN(xb_ld(&bar[XB_TOPGEN]) == tg, bar);
            __builtin_amdgcn_fence(__ATOMIC_ACQUIRE, "agent");
            xb_add(&bar[XB_XGEN(b.x)], 1u);
            asm volatile("s_waitcnt vmcnt(0)" ::: "memory");
        } else {
            XB_SPIN(xb_ld(&bar[XB_XGEN(b.x)]) == gen, bar);
            __builtin_amdgcn_fence(__ATOMIC_ACQUIRE, "agent");
            asm volatile("s_waitcnt vmcnt(0)" ::: "memory");
        }
    }
    __syncthreads();
}

struct Args { const float* in[17]; float* out; unsigned char* ws; int ph_lo, ph_hi; };
struct Frame {
    LAS unsigned char* lds;
    int tid, lane, wave, G, blk;
    const float *xp, *xs, *ca, *cb1, *cb2, *cb3, *relb, *ng, *win, *qga, *kga, *snk, *qgb, *kgb, *wua, *wub, *wout;
    float* out;
    bf16 *WIN, *WUP, *WOUT, *HB, *Q, *KA, *VA, *KB, *VB, *Gt, *OG, *AB, *T, *MG;
    float* LG;
};
__device__ __forceinline__ float wave_sum(float v) {
#pragma unroll
    for (int o = 1; o < 64; o <<= 1) v += __shfl_xor(v, o);
    return v;
}
__device__ __forceinline__ float wave_max(float v) {
#pragma unroll
    for (int o = 1; o < 64; o <<= 1) v = fmaxf(v, __shfl_xor(v, o));
    return v;
}

__device__ __forceinline__ void p0_transpose_item(const float* W, int N, bf16* WT, int ldo, int koff, int rowbase, int k0, int n0, LAS float* scr, int lane) {
#pragma unroll 8
    for (int i = 0; i < 32; ++i) { const int kk = 2 * i + (lane >> 5); scr[kk * 33 + (lane & 31)] = W[(size_t)(k0 + kk) * N + n0 + (lane & 31)]; }
    LDS_WAIT(); asm volatile("" ::: "memory");
    const int c = lane & 7;
#pragma unroll
    for (int j = 0; j < 4; ++j) { const int n = (lane >> 3) + 8 * j; const LAS float* s = scr + (8 * c) * 33 + n;
        u32x4 o; o.x = cvtpk(s[0 * 33], s[1 * 33]); o.y = cvtpk(s[2 * 33], s[3 * 33]); o.z = cvtpk(s[4 * 33], s[5 * 33]); o.w = cvtpk(s[6 * 33], s[7 * 33]);
        *(u32x4*)(WT + (size_t)(rowbase + n) * ldo + koff + k0 + 8 * c) = o; }
    LDS_WAIT(); asm volatile("" ::: "memory");
}
__device__ __forceinline__ void p0_prologue(Frame& F) {
    LAS float* scr = (LAS float*)(F.lds + F.wave * 16384);
    const int gw = F.blk * NWAVES + F.wave, NGW = F.G * NWAVES;
    constexpr int I_IN = (DM / 64) * (CIN / 32), I_UP = (512 / 64) * (DM / 32), I_OUT = (DM / 64) * (DM / 32);
    constexpr int NITEMS = I_IN + 2 * I_UP + I_OUT;
    for (int it = gw; it < NITEMS; it += NGW) {
        int r = it;
        if (r < I_IN) { const int nblk = CIN / 32, kb = r / nblk, nb = r % nblk, n0 = 32 * nb;
            const int rb = (n0 & ~255) + 128 * ((n0 >> 5) & 1) + 32 * ((n0 >> 6) & 3);
            p0_transpose_item(F.win, CIN, F.WIN, DM, 0, rb, 64 * kb, n0, scr, F.lane); continue; }
        r -= I_IN;
        if (r < I_UP) { const int nblk = DM / 32, kb = r / nblk, nb = r % nblk; p0_transpose_item(F.wua, DM, F.WUP, DM, 0, 32 * nb, 64 * kb, 32 * nb, scr, F.lane); continue; }
        r -= I_UP;
        if (r < I_UP) { const int nblk = DM / 32, kb = r / nblk, nb = r % nblk; p0_transpose_item(F.wub, DM, F.WUP, DM, 512, 32 * nb, 64 * kb, 32 * nb, scr, F.lane); continue; }
        r -= I_UP;
        { const int nblk = DM / 32, kb = r / nblk, nb = r % nblk; p0_transpose_item(F.wout, DM, F.WOUT, DM, 0, 32 * nb, 64 * kb, 32 * nb, scr, F.lane); }
    }
    f32x4 gv[4];
#pragma unroll
    for (int j = 0; j < 4; ++j) gv[j] = *((const f32x4*)F.ng + F.lane + 64 * j);
    for (int m = gw; m < MR; m += NGW) {
        const float* xrow = (m < NP) ? F.xp + (size_t)m * DM : F.xs + (size_t)(m - NP) * DM;
        const f32x4* xr = (const f32x4*)xrow + F.lane;
        f32x4 v[4]; float s = 0.f;
#pragma unroll
        for (int j = 0; j < 4; ++j) { v[j] = xr[64 * j]; s += (v[j].x * v[j].x + v[j].y * v[j].y) + (v[j].z * v[j].z + v[j].w * v[j].w); }
        const float rs = 1.0f / sqrtf(wave_sum(s) * (1.f / DM) + 1e-6f);
        unsigned long long* o8 = (unsigned long long*)(F.HB + (size_t)m * DM) + F.lane;
#pragma unroll
        for (int j = 0; j < 4; ++j) { const f32x4 w = v[j] * rs * gv[j]; o8[64 * j] = (unsigned long long)cvtpk(w.x, w.y) | ((unsigned long long)cvtpk(w.z, w.w) << 32); }
    }
}

struct SchedP1 {
    pg8::TileOrder o; const bf16* A; const bf16* B;
    __device__ __forceinline__ bool next(int i, pg8::Unit& u) const { u.kind = 0; return o.tile(i, u.pm, u.pn); }
    __device__ __forceinline__ void ptrs(const pg8::Unit& u, const char*& a, const char*& b) const { a = (const char*)(A + (size_t)u.pm * 256 * DM); b = (const char*)(B + (size_t)u.pn * 256 * DM); }
};
struct EpiP1 {
    bf16 *Q, *KA, *VA, *KB, *VB, *Gt; float* out; const float *qga, *kga, *qgb, *kgb;
    __device__ __forceinline__ void operator()(const f32x4 (&acc)[2][2][4][2], const pg8::Unit& u, int wr, int wc, int fr, int fq) const {
        const int pn = u.pn;
        int mode, pitch, col, ogrp = -1, okv = 0, ohead = 0; bf16* dst; const float* gain = nullptr; float scale = 1.f;
        if (pn < 2) { mode = 0; dst = Q; pitch = QP; col = 256 * pn + 64 * wc; gain = qga; scale = QSCALE; }
        else if (pn == 2) { if (wc < 2) { mode = 0; dst = KA; pitch = KAP; col = 64 * wc; gain = kga; ogrp = 0; okv = 0; ohead = wc; }
                            else { mode = 1; dst = VA; pitch = KAP; col = 64 * (wc - 2); ogrp = 0; okv = 1; ohead = wc - 2; } }
        else if (pn < 5) { mode = 2; dst = Gt; pitch = GP; col = 256 * (pn - 3) + 64 * wc; }
        else if (pn < 11) { mode = 0; dst = Q; pitch = QP; col = 512 + 256 * (pn - 5) + 64 * wc; gain = qgb + 64 * ((pn - 5) >> 1); scale = QSCALE; }
        else if (pn < 17) { const int g = (pn - 11) >> 1; mode = 0; dst = KB; pitch = KBP; col = 256 * (pn - 11) + 64 * wc; gain = kgb + 64 * g; ogrp = 1 + g; okv = 0; ohead = 4 * ((pn - 11) & 1) + wc; }
        else if (pn < 23) { const int g = (pn - 17) >> 1; mode = 1; dst = VB; pitch = KBP; col = 256 * (pn - 17) + 64 * wc; ogrp = 1 + g; okv = 1; ohead = 4 * ((pn - 17) & 1) + wc; }
        else if (pn < 25) { mode = 2; dst = Gt; pitch = GP; col = 512 + 256 * (pn - 23) + 64 * wc; }
        else { mode = 3; dst = Gt; pitch = GP; col = 1024 + 256 * (pn - 25) + 64 * wc; }
        float gvv[16];
        if (mode == 0) {
#pragma unroll
            for (int bj = 0; bj < 2; ++bj) { const f32x4 g0 = *(const f32x4*)(gain + 32 * bj + 8 * fq), g1 = *(const f32x4*)(gain + 32 * bj + 8 * fq + 4);
                gvv[bj * 8 + 0] = g0.x * scale; gvv[bj * 8 + 1] = g0.y * scale; gvv[bj * 8 + 2] = g0.z * scale; gvv[bj * 8 + 3] = g0.w * scale;
                gvv[bj * 8 + 4] = g1.x * scale; gvv[bj * 8 + 5] = g1.y * scale; gvv[bj * 8 + 6] = g1.z * scale; gvv[bj * 8 + 7] = g1.w * scale; }
        }
        const int W = (ogrp <= 1) ? 128 : (ogrp == 2 ? 512 : 2048), H = (ogrp == 0) ? 2 : 8;
        const size_t obp = (ogrp == 0) ? OUT_PA : (ogrp == 1) ? OUT_PB1 : (ogrp == 2) ? OUT_PB2 : OUT_PB3;
        const size_t obs = (ogrp == 0) ? OUT_SA : (ogrp == 1) ? OUT_SB1 : (ogrp == 2) ? OUT_SB2 : OUT_SB3;
#pragma unroll
        for (int ai = 0; ai < 2; ++ai)
#pragma unroll
            for (int m = 0; m < 4; ++m) {
                const int row = u.pm * 256 + ai * 128 + wr * 64 + m * 16 + fr;
                float v[16];
#pragma unroll
                for (int bj = 0; bj < 2; ++bj)
#pragma unroll
                    for (int n = 0; n < 2; ++n) { const f32x4 a = acc[ai][bj][m][n]; v[bj * 8 + n * 4 + 0] = a.x; v[bj * 8 + n * 4 + 1] = a.y; v[bj * 8 + n * 4 + 2] = a.z; v[bj * 8 + n * 4 + 3] = a.w; }
                if (mode == 0) {
                    float ss = 0.f;
#pragma unroll
                    for (int e = 0; e < 16; ++e) ss += v[e] * v[e];
                    ss += __shfl_xor(ss, 16); ss += __shfl_xor(ss, 32);
                    const float rinv = 1.0f / sqrtf(ss * (1.f / 64.f) + 1e-6f);
#pragma unroll
                    for (int e = 0; e < 16; ++e) v[e] = v[e] * rinv * gvv[e];
                } else if (mode == 2) {
#pragma unroll
                    for (int e = 0; e < 16; ++e) v[e] = v[e] / (1.f + __expf(-v[e]));
                } else if (mode == 3) {
#pragma unroll
                    for (int e = 0; e < 16; ++e) v[e] = 1.f / (1.f + __expf(-v[e]));
                }
                bf16* rowp = dst + (size_t)row * pitch + col + 8 * fq;
#pragma unroll
                for (int bj = 0; bj < 2; ++bj) { u32x4 w; w.x = cvtpk(v[bj * 8 + 0], v[bj * 8 + 1]); w.y = cvtpk(v[bj * 8 + 2], v[bj * 8 + 3]); w.z = cvtpk(v[bj * 8 + 4], v[bj * 8 + 5]); w.w = cvtpk(v[bj * 8 + 6], v[bj * 8 + 7]);
                    *(u32x4*)(rowp + 32 * bj) = w; }
                if (ogrp >= 0) {
                    float* o = nullptr;
                    if (row < NP) { const int b = row >> 12, t = row & 4095; if (t >= SEQ - W) o = out + obp + ((size_t)((b * W + t - (SEQ - W)) * 2 + okv) * H + ohead) * 64; }
                    else { const int rs = row - NP; o = out + obs + ((size_t)(rs * 2 + okv) * H + ohead) * 64; }
                    if (o) {
#pragma unroll
                        for (int bj = 0; bj < 2; ++bj) { *(f32x4*)(o + 32 * bj + 8 * fq) = (f32x4){v[bj * 8 + 0], v[bj * 8 + 1], v[bj * 8 + 2], v[bj * 8 + 3]};
                            *(f32x4*)(o + 32 * bj + 8 * fq + 4) = (f32x4){v[bj * 8 + 4], v[bj * 8 + 5], v[bj * 8 + 6], v[bj * 8 + 7]}; }
                    }
                }
            }
    }
};

struct SchedP3 {
    pg8::TileOrder o; const bf16* A; const bf16* B;
    __device__ __forceinline__ bool next(int i, pg8::Unit& u) const { u.kind = i & 1; return o.tile(i >> 1, u.pm, u.pn); }
    __device__ __forceinline__ void ptrs(const pg8::Unit& u, const char*& a, const char*& b) const { a = (const char*)(A + (size_t)u.pm * 256 * DM + 512 * u.kind); b = (const char*)(B + (size_t)u.pn * 256 * DM + 512 * u.kind); }
};
struct EpiP3 {
    const bf16* Gt; bf16* T; bf16* MG;
    __device__ __forceinline__ void operator()(const f32x4 (&acc)[2][2][4][2], const pg8::Unit& u, int wr, int wc, int fr, int fq) const {
        const int kind = u.kind;
#pragma unroll
        for (int ai = 0; ai < 2; ++ai)
#pragma unroll
            for (int m = 0; m < 4; ++m) {
                const int row = u.pm * 256 + ai * 128 + wr * 64 + m * 16 + fr;
#pragma unroll
                for (int bj = 0; bj < 2; ++bj) {
                    const int c0 = u.pn * 256 + bj * 128 + wc * 32 + 8 * fq;
                    const u32x4 g = *(const u32x4*)(Gt + (size_t)row * GP + (kind ? 2048 : 1024) + c0);
                    const f32x4 a0 = acc[ai][bj][m][0], a1 = acc[ai][bj][m][1];
                    float r0 = a0.x * bflo(g.x), r1 = a0.y * bfhi(g.x), r2 = a0.z * bflo(g.y), r3 = a0.w * bfhi(g.y), r4 = a1.x * bflo(g.z), r5 = a1.y * bfhi(g.z), r6 = a1.z * bflo(g.w), r7 = a1.w * bfhi(g.w);
                    if (kind) { const u32x4 t = *(const u32x4*)(T + (size_t)row * DM + c0);
                        r0 += bflo(t.x); r1 += bfhi(t.x); r2 += bflo(t.y); r3 += bfhi(t.y); r4 += bflo(t.z); r5 += bfhi(t.z); r6 += bflo(t.w); r7 += bfhi(t.w); }
                    u32x4 w; w.x = cvtpk(r0, r1); w.y = cvtpk(r2, r3); w.z = cvtpk(r4, r5); w.w = cvtpk(r6, r7);
                    *(u32x4*)((kind ? MG : T) + (size_t)row * DM + c0) = w;
                }
            }
    }
};
struct SchedP4 {
    pg8::TileOrder o; const bf16* A; const bf16* B;
    __device__ __forceinline__ bool next(int i, pg8::Unit& u) const { u.kind = 0; return o.tile(i, u.pm, u.pn); }
    __device__ __forceinline__ void ptrs(const pg8::Unit& u, const char*& a, const char*& b) const { a = (const char*)(A + (size_t)u.pm * 256 * DM); b = (const char*)(B + (size_t)u.pn * 256 * DM); }
};
struct EpiP4 {
    const float* xp; const float* xs; float* out;
    __device__ __forceinline__ void operator()(const f32x4 (&acc)[2][2][4][2], const pg8::Unit& u, int wr, int wc, int fr, int fq) const {
#pragma unroll
        for (int ai = 0; ai < 2; ++ai)
#pragma unroll
            for (int m = 0; m < 4; ++m) {
                const int row = u.pm * 256 + ai * 128 + wr * 64 + m * 16 + fr;
                const float* xrow = (row < NP) ? xp + (size_t)row * DM : xs + (size_t)(row - NP) * DM;
                float* orow = out + (size_t)row * DM;
#pragma unroll
                for (int bj = 0; bj < 2; ++bj)
#pragma unroll
                    for (int n = 0; n < 2; ++n) { const int c = u.pn * 256 + bj * 128 + wc * 32 + 16 * n + 4 * fq;
                        *(f32x4*)(orow + c) = *(const f32x4*)(xrow + c) + acc[ai][bj][m][n]; }
            }
    }
};

__device__ __forceinline__ int t5_bucket(int dist) {
    if (dist < 16) return dist;
    const float df = (float)dist;
    int large = 16 + (int)(__log2f(df * (1.f / 16.f)) * (16.f / 7.f));
    return large < 31 ? large : 31;
}
struct AttnCtx { LAS float* tab; LAS unsigned char* vt; LAS float* lx; int lane, r32, hi; float mref2; };
__device__ __forceinline__ int crow(int r, int hi) { return (r & 3) + 8 * (r >> 2) + 4 * hi; }
__device__ __forceinline__ s16x4 vtr(const LAS unsigned char* p) { return __builtin_bit_cast(s16x4, __builtin_amdgcn_ds_read_tr16_b64_v4i16((LAS s16x4*)p)); }

template <bool IS_A>
__device__ __forceinline__ void attn_prompt_item(const AttnCtx& c, const bf16* qp, long qstride, const bf16* kp, const bf16* vp, long kstride, int kt0, const LAS float* tb, float sinkterm,
                                                 bf16* op, long ostride, const bf16* gp, long gstride, float* lgp, long lgstride) {
    const int lane = c.lane, r32 = c.r32, hi = c.hi;
    bf16x8 qf[4];
#pragma unroll
    for (int d0 = 0; d0 < 4; ++d0) qf[d0] = *(const bf16x8*)(qp + r32 * qstride + 16 * d0 + 8 * hi);
    const int pi = (r32 & 19) | ((r32 & 4) << 1) | ((r32 & 8) >> 1);
    const bf16* kl = kp + pi * kstride + 8 * hi;
    const int vkey = lane >> 3, vch = lane & 7;
    const bf16* vl = vp + vkey * kstride + 8 * vch;
    LAS unsigned char* vw = c.vt + (vch >> 2) * 2048 + vkey * 64 + (vch & 3) * 16;
    const LAS unsigned char* vr = c.vt + (8 * hi + ((lane & 15) >> 2)) * 64 + ((lane >> 4) & 1) * 32 + (lane & 3) * 8;
    const LAS float* tl = tb + 32 + r32 - 8 * hi;
    f32x16 O0, O1;
#pragma unroll
    for (int r = 0; r < 16; ++r) { O0[r] = 0.f; O1[r] = 0.f; }
    float lsum = 0.f;
    bf16x8 kf[4]; u32x4 vraw[4];
    {   const bf16* kb = kl + (long)(32 * kt0) * kstride; const bf16* vb = vl + (long)(32 * kt0) * kstride;
#pragma unroll
        for (int d0 = 0; d0 < 4; ++d0) kf[d0] = *(const bf16x8*)(kb + 16 * d0);
#pragma unroll
        for (int i = 0; i < 4; ++i) vraw[i] = *(const u32x4*)(vb + (long)(8 * i) * kstride); }
    for (int kt = kt0; kt < 5; ++kt) {
        bf16x8 kn[4]; u32x4 vn[4];
        if (kt < 4) { const bf16* kb = kl + (long)(32 * (kt + 1)) * kstride; const bf16* vb = vl + (long)(32 * (kt + 1)) * kstride;
#pragma unroll
            for (int d0 = 0; d0 < 4; ++d0) kn[d0] = *(const bf16x8*)(kb + 16 * d0);
#pragma unroll
            for (int i = 0; i < 4; ++i) vn[i] = *(const u32x4*)(vb + (long)(8 * i) * kstride); }
        else {
#pragma unroll
            for (int d0 = 0; d0 < 4; ++d0) kn[d0] = kf[d0];
#pragma unroll
            for (int i = 0; i < 4; ++i) vn[i] = vraw[i]; }
        f32x16 S; const LAS float* tk = tl + (128 - 32 * kt);
#pragma unroll
        for (int r = 0; r < 16; ++r) S[r] = tk[-16 * (r >> 3) - (r & 7)];
#pragma unroll
        for (int d0 = 0; d0 < 4; ++d0) S = __builtin_amdgcn_mfma_f32_32x32x16_bf16(kf[d0], qf[d0], S, 0, 0, 0);
#pragma unroll
        for (int i = 0; i < 4; ++i) *(LAS u32x4*)(vw + i * 512) = vraw[i];
        float ps = 0.f;
#pragma unroll
        for (int r = 0; r < 16; ++r) { S[r] = fexp2(S[r]); ps += S[r]; }
        lsum += ps;
        u32x4 pw0, pw1;
        pw0.x = cvtpk(S[0], S[1]); pw0.y = cvtpk(S[2], S[3]); pw0.z = cvtpk(S[4], S[5]); pw0.w = cvtpk(S[6], S[7]);
        pw1.x = cvtpk(S[8], S[9]); pw1.y = cvtpk(S[10], S[11]); pw1.z = cvtpk(S[12], S[13]); pw1.w = cvtpk(S[14], S[15]);
        s16x4 a0 = vtr(vr + 0), a1 = vtr(vr + 256), b0 = vtr(vr + 1024), b1 = vtr(vr + 1280), c0 = vtr(vr + 2048), c1 = vtr(vr + 2048 + 256), d0v = vtr(vr + 2048 + 1024), d1v = vtr(vr + 2048 + 1280);
#define PKV(x, y) (bf16x8){x[0], x[1], x[2], x[3], y[0], y[1], y[2], y[3]}
        O0 = __builtin_amdgcn_mfma_f32_32x32x16_bf16(__builtin_bit_cast(bf16x8, pw0), PKV(a0, a1), O0, 0, 0, 0);
        O0 = __builtin_amdgcn_mfma_f32_32x32x16_bf16(__builtin_bit_cast(bf16x8, pw1), PKV(b0, b1), O0, 0, 0, 0);
        O1 = __builtin_amdgcn_mfma_f32_32x32x16_bf16(__builtin_bit_cast(bf16x8, pw0), PKV(c0, c1), O1, 0, 0, 0);
        O1 = __builtin_amdgcn_mfma_f32_32x32x16_bf16(__builtin_bit_cast(bf16x8, pw1), PKV(d0v, d1v), O1, 0, 0, 0);
#undef PKV
#pragma unroll
        for (int d0 = 0; d0 < 4; ++d0) kf[d0] = kn[d0];
#pragma unroll
        for (int i = 0; i < 4; ++i) vraw[i] = vn[i];
    }
    float lt = lsum + __shfl_xor(lsum, 32);
    if (IS_A) lt += sinkterm;
    if (hi == 0) { c.lx[r32] = lt; if (!IS_A) lgp[r32 * lgstride] = lt; }
    LAS bf16* stg = (LAS bf16*)c.vt;
#pragma unroll
    for (int r = 0; r < 16; ++r) { const int q = crow(r, hi); float li = 1.f; if (IS_A) li = 1.0f / c.lx[q];
        stg[q * 64 + r32] = (bf16)(cvtpk(O0[r] * li, 0.f) & 0xffffu); stg[q * 64 + 32 + r32] = (bf16)(cvtpk(O1[r] * li, 0.f) & 0xffffu); }
#pragma unroll
    for (int i = 0; i < 4; ++i) { const int row = 8 * i + (lane >> 3), ch = lane & 7;
        u32x4 w = *(const LAS u32x4*)(c.vt + row * 128 + ch * 16);
        if (IS_A) { const u32x4 g = *(const u32x4*)(gp + row * gstride + 8 * ch);
            w.x = cvtpk(bflo(w.x) * bflo(g.x), bfhi(w.x) * bfhi(g.x)); w.y = cvtpk(bflo(w.y) * bflo(g.y), bfhi(w.y) * bfhi(g.y));
            w.z = cvtpk(bflo(w.z) * bflo(g.z), bfhi(w.z) * bfhi(g.z)); w.w = cvtpk(bflo(w.w) * bflo(g.w), bfhi(w.w) * bfhi(g.w)); }
        *(u32x4*)(op + row * ostride + 8 * ch) = w; }
}

__device__ __forceinline__ float red8(float s) { s += __shfl_xor(s, 1); s += __shfl_xor(s, 2); s += __shfl_xor(s, 4); return s; }
__device__ __forceinline__ float red32(float s) { s += __shfl_xor(s, 1); s += __shfl_xor(s, 2); s += __shfl_xor(s, 4); s += __shfl_xor(s, 8); s += __shfl_xor(s, 16); return s; }

__device__ __forceinline__ void dec_b_strided(const AttnCtx& c, const Frame& F, int g, int n, int t) {
    const int hd = c.lane >> 3, sub = c.lane & 7, row = NP + n * 4 + t;
    const int L = (g == 2) ? 512 : 2048, d = (g == 2) ? 4 : 16;
    const float* cache = (g == 2) ? F.cb2 : F.cb3;
    float qv[8];
    { const u32x4 qw = *(const u32x4*)(F.Q + (size_t)row * QP + 512 + (g - 1) * 512 + hd * 64 + sub * 8);
      qv[0] = bflo(qw.x); qv[1] = bfhi(qw.x); qv[2] = bflo(qw.y); qv[3] = bfhi(qw.y); qv[4] = bflo(qw.z); qv[5] = bfhi(qw.z); qv[6] = bflo(qw.w); qv[7] = bfhi(qw.w); }
    const LAS float* tb = c.tab + (8 * g + hd) * 192 + 32;
    const float* cb = cache + (size_t)n * L * 1024 + hd * 64 + sub * 8;
    const float* kn = F.out + ((g == 2) ? OUT_SB2 : OUT_SB3) + (size_t)(n * 4 + t) * 1024 + hd * 64 + sub * 8;
    float acc[8]; float l = 0.f;
#pragma unroll
    for (int e = 0; e < 8; ++e) acc[e] = 0.f;
    for (int j0 = 0; j0 < 128; j0 += 4) {
        f32x4 k0[4], k1[4], v0[4], v1[4];
#pragma unroll
        for (int u = 0; u < 4; ++u) { const int j = j0 + u; const float* rp = (j == 0) ? kn : cb + (size_t)(L + t - j * d) * 1024;
            k0[u] = *(const f32x4*)rp; k1[u] = *(const f32x4*)(rp + 4); v0[u] = *(const f32x4*)(rp + 512); v1[u] = *(const f32x4*)(rp + 516); }
#pragma unroll
        for (int u = 0; u < 4; ++u) {
            float s = qv[0] * k0[u].x + qv[1] * k0[u].y + qv[2] * k0[u].z + qv[3] * k0[u].w + qv[4] * k1[u].x + qv[5] * k1[u].y + qv[6] * k1[u].z + qv[7] * k1[u].w;
            s = red8(s);
            const float p = fexp2(s + tb[j0 + u]); l += p;
            acc[0] += p * v0[u].x; acc[1] += p * v0[u].y; acc[2] += p * v0[u].z; acc[3] += p * v0[u].w; acc[4] += p * v1[u].x; acc[5] += p * v1[u].y; acc[6] += p * v1[u].z; acc[7] += p * v1[u].w;
        }
    }
    u32x4 w; w.x = cvtpk(acc[0], acc[1]); w.y = cvtpk(acc[2], acc[3]); w.z = cvtpk(acc[4], acc[5]); w.w = cvtpk(acc[6], acc[7]);
    *(u32x4*)(F.OG + ((size_t)(g - 1) * MR + row) * OGP + hd * 64 + sub * 8) = w;
    if (sub == 0) F.LG[((size_t)(g - 1) * MR + row) * 8 + hd] = l;
}
__device__ __forceinline__ void dec_b_dense(const AttnCtx& c, const Frame& F, int n) {
    const int hd = c.lane >> 3, sub = c.lane & 7, row0 = NP + n * 4;
    float qv[4][8];
#pragma unroll
    for (int t = 0; t < 4; ++t) { const u32x4 qw = *(const u32x4*)(F.Q + (size_t)(row0 + t) * QP + 512 + hd * 64 + sub * 8);
      qv[t][0] = bflo(qw.x); qv[t][1] = bfhi(qw.x); qv[t][2] = bflo(qw.y); qv[t][3] = bfhi(qw.y); qv[t][4] = bflo(qw.z); qv[t][5] = bfhi(qw.z); qv[t][6] = bflo(qw.w); qv[t][7] = bfhi(qw.w); }
    const LAS float* tb = c.tab + (8 * 1 + hd) * 192 + 32;
    const float* cb = F.cb1 + (size_t)n * 128 * 1024 + hd * 64 + sub * 8;
    const float* kn = F.out + OUT_SB1 + (size_t)(n * 4) * 1024 + hd * 64 + sub * 8;
    float acc[4][8]; float l[4];
#pragma unroll
    for (int t = 0; t < 4; ++t) { l[t] = 0.f;
#pragma unroll
        for (int e = 0; e < 8; ++e) acc[t][e] = 0.f; }
    for (int e0 = 0; e0 < 132; e0 += 4) {
        f32x4 k0[4], k1[4], v0[4], v1[4];
#pragma unroll
        for (int u = 0; u < 4; ++u) { const int e = e0 + u; const int tn = (e - 127) < 3 ? (e - 127) : 3; const float* rp = (e < 127) ? cb + (size_t)(e + 1) * 1024 : kn + (size_t)tn * 1024;
            k0[u] = *(const f32x4*)rp; k1[u] = *(const f32x4*)(rp + 4); v0[u] = *(const f32x4*)(rp + 512); v1[u] = *(const f32x4*)(rp + 516); }
#pragma unroll
        for (int u = 0; u < 4; ++u) {
            const int e = e0 + u;
#pragma unroll
            for (int t = 0; t < 4; ++t) {
                float s = qv[t][0] * k0[u].x + qv[t][1] * k0[u].y + qv[t][2] * k0[u].z + qv[t][3] * k0[u].w + qv[t][4] * k1[u].x + qv[t][5] * k1[u].y + qv[t][6] * k1[u].z + qv[t][7] * k1[u].w;
                s = red8(s);
                const int j = 127 + t - e;
                const float p = fexp2(s + tb[j]); l[t] += p;
                acc[t][0] += p * v0[u].x; acc[t][1] += p * v0[u].y; acc[t][2] += p * v0[u].z; acc[t][3] += p * v0[u].w; acc[t][4] += p * v1[u].x; acc[t][5] += p * v1[u].y; acc[t][6] += p * v1[u].z; acc[t][7] += p * v1[u].w;
            }
        }
    }
#pragma unroll
    for (int t = 0; t < 4; ++t) {
        u32x4 w; w.x = cvtpk(acc[t][0], acc[t][1]); w.y = cvtpk(acc[t][2], acc[t][3]); w.z = cvtpk(acc[t][4], acc[t][5]); w.w = cvtpk(acc[t][6], acc[t][7]);
        *(u32x4*)(F.OG + ((size_t)0 * MR + row0 + t) * OGP + hd * 64 + sub * 8) = w;
        if (sub == 0) F.LG[((size_t)0 * MR + row0 + t) * 8 + hd] = l[t];
    }
}
__device__ __forceinline__ void dec_a(const AttnCtx& c, const Frame& F, int n, int t) {
    const int kvh = c.lane >> 5, dl = c.lane & 31, row = NP + n * 4 + t;
    float q0[4], q1[4];
#pragma unroll
    for (int i = 0; i < 4; ++i) { const unsigned qw = *(const unsigned*)(F.Q + (size_t)row * QP + (kvh * 4 + i) * 64 + 2 * dl); q0[i] = bflo(qw); q1[i] = bfhi(qw); }
    const LAS float* tb = c.tab + (kvh * 4) * 192 + 32;
    const float* cb = F.ca + (size_t)n * 128 * 256 + kvh * 64 + 2 * dl;
    const float* kn = F.out + OUT_SA + (size_t)(n * 4) * 256 + kvh * 64 + 2 * dl;
    float a0[4], a1[4], l[4];
#pragma unroll
    for (int i = 0; i < 4; ++i) { a0[i] = 0.f; a1[i] = 0.f; l[i] = 0.f; }
    for (int e0 = 0; e0 < 132; e0 += 4) {
        f32x2 kk[4], vv[4];
#pragma unroll
        for (int u = 0; u < 4; ++u) { const int e = e0 + u; const int tn = (e - 127) < 3 ? (e - 127) : 3; const float* rp = (e < 127) ? cb + (size_t)(e + 1) * 256 : kn + (size_t)tn * 256;
            kk[u] = *(const f32x2*)rp; vv[u] = *(const f32x2*)(rp + 128); }
#pragma unroll
        for (int u = 0; u < 4; ++u) {
            const int j = 127 + t - (e0 + u);
#pragma unroll
            for (int i = 0; i < 4; ++i) {
                float s = red32(q0[i] * kk[u].x + q1[i] * kk[u].y);
                const float p = fexp2(s + tb[i * 192 + j]); l[i] += p; a0[i] += p * vv[u].x; a1[i] += p * vv[u].y;
            }
        }
    }
#pragma unroll
    for (int i = 0; i < 4; ++i) {
        const int head = kvh * 4 + i;
        const float lt = l[i] + fexp2(F.snk[head] * LOG2E - c.mref2);
        const float li = 1.0f / lt;
        const unsigned g = *(const unsigned*)(F.Gt + (size_t)row * GP + head * 64 + 2 * dl);
        *(unsigned*)(F.AB + (size_t)row * DM + head * 64 + 2 * dl) = cvtpk(a0[i] * li * bflo(g), a1[i] * li * bfhi(g));
    }
}

__device__ __forceinline__ void p2_attention(Frame& F) {
    LAS float* tab = (LAS float*)(F.lds + AT_TAB);
    LAS float* red = (LAS float*)(F.lds + AT_RED);
    volatile LAS unsigned* qctr = (volatile LAS unsigned*)(F.lds + AT_RED + 128);
    {
        float bm = fmaxf(F.relb[F.tid], F.relb[F.tid + 512]);
        if (F.tid < 8) bm = fmaxf(bm, F.snk[F.tid]);
        float gm = 0.f;
        if (F.tid < 64) gm = fabsf(F.qga[F.tid] * F.kga[F.tid]);
        else if (F.tid < 256) gm = fabsf(F.qgb[F.tid - 64] * F.kgb[F.tid - 64]);
        bm = wave_max(bm); gm = wave_max(gm);
        if (F.lane == 0) { red[F.wave] = bm; red[8 + F.wave] = gm; }
        if (F.tid == 0) *qctr = 0u;
    }
    __syncthreads();
    float mref2;
    { float bm = red[0], gm = red[8];
#pragma unroll
      for (int w = 1; w < 8; ++w) { bm = fmaxf(bm, red[w]); gm = fmaxf(gm, red[8 + w]); }
      mref2 = (8.f * gm + bm) * LOG2E; }
    for (int idx = F.tid; idx < 32 * 192; idx += NTHR) {
        const int tb = idx / 192, e = idx % 192, j = e - 32, grp = tb >> 3, h = tb & 7;
        const int d = (grp <= 1) ? 1 : (grp == 2 ? 4 : 16), col = (grp == 0) ? h : 8 + (grp - 1) * 8 + h;
        float v = NEGBIG;
        if (j >= 0 && j <= 127) v = F.relb[t5_bucket(j * d) * 32 + col] * LOG2E - mref2;
        tab[idx] = v;
    }
    __syncthreads();
    AttnCtx c; c.tab = tab; c.vt = F.lds + AT_VT + F.wave * 4096; c.lx = (LAS float*)(F.lds + AT_LX + F.wave * 128); c.lane = F.lane; c.r32 = F.lane & 31; c.hi = F.lane >> 5; c.mref2 = mref2;
    constexpr int NDEC = 512 + 512 + 128 + 512, NITEM = 16384;
    const int ndec = (F.blk < NDEC) ? (NDEC - 1 - F.blk) / F.G + 1 : 0;
    const int ipb = (((NITEM + F.G - 1) / F.G) + 7) & ~7;
    for (;;) {
        unsigned job = 0;
        if (F.lane == 0) job = __hip_atomic_fetch_add((LAS unsigned*)qctr, 1u, __ATOMIC_RELAXED, __HIP_MEMORY_SCOPE_WORKGROUP);
        job = (unsigned)__builtin_amdgcn_readfirstlane((int)job);
        if ((int)job < ndec) {
            const int u = F.blk + F.G * (int)job;
            if (u < 512) dec_b_strided(c, F, 3, u >> 2, u & 3);
            else if (u < 1024) dec_b_strided(c, F, 2, (u - 512) >> 2, (u - 512) & 3);
            else if (u < 1152) dec_b_dense(c, F, u - 1024);
            else dec_a(c, F, (u - 1152) >> 2, (u - 1152) & 3);
            continue;
        }
        const int pi = (int)job - ndec;
        if (pi >= ipb) break;
        const int item = F.blk * ipb + pi;
        if (item >= NITEM) break;
        const int qt = item & 127, h = (item >> 7) & 7, b = (item >> 10) & 3, grp = item >> 12;
        const int d = (grp <= 1) ? 1 : (grp == 2 ? 4 : 16);
        const int tpc = 128 / d, cls = qt / tpc, m0 = 32 * (qt % tpc);
        const long tok0 = (long)b * SEQ + cls + (long)d * m0;
        const int kt0 = (m0 >= 128) ? 0 : 4 - (m0 >> 5);
        const LAS float* tb = tab + (grp * 8 + h) * 192;
        if (grp == 0) {
            const int kvh = h >> 2;
            attn_prompt_item<true>(c, F.Q + tok0 * QP + h * 64, (long)d * QP, F.KA + (tok0 - 128L * d) * KAP + kvh * 64, F.VA + (tok0 - 128L * d) * KAP + kvh * 64, (long)d * KAP, kt0, tb,
                                   fexp2(F.snk[h] * LOG2E - mref2), F.AB + tok0 * DM + h * 64, (long)d * DM, F.Gt + tok0 * GP + h * 64, (long)d * GP, nullptr, 0);
        } else {
            const int g = grp - 1;
            attn_prompt_item<false>(c, F.Q + tok0 * QP + 512 + g * 512 + h * 64, (long)d * QP, F.KB + (tok0 - 128L * d) * KBP + g * 512 + h * 64, F.VB + (tok0 - 128L * d) * KBP + g * 512 + h * 64, (long)d * KBP, kt0, tb,
                                    0.f, F.OG + ((size_t)g * MR + tok0) * OGP + h * 64, (long)d * OGP, nullptr, 0, F.LG + ((size_t)g * MR + tok0) * 8 + h, (long)d * 8);
        }
    }
}
__device__ __forceinline__ void p2b_combine(Frame& F) {
    const int gw = F.blk * NWAVES + F.wave, NGW = F.G * NWAVES, hd = F.lane >> 3;
    for (int row = gw; row < MR; row += NGW) {
        float lt = 0.f; float acc[8];
#pragma unroll
        for (int e = 0; e < 8; ++e) acc[e] = 0.f;
#pragma unroll
        for (int g = 0; g < 3; ++g) { lt += F.LG[((size_t)g * MR + row) * 8 + hd];
            const u32x4 w = *(const u32x4*)(F.OG + ((size_t)g * MR + row) * OGP + F.lane * 8);
            acc[0] += bflo(w.x); acc[1] += bfhi(w.x); acc[2] += bflo(w.y); acc[3] += bfhi(w.y); acc[4] += bflo(w.z); acc[5] += bfhi(w.z); acc[6] += bflo(w.w); acc[7] += bfhi(w.w); }
        const float li = 1.0f / lt;
        const u32x4 g = *(const u32x4*)(F.Gt + (size_t)row * GP + 512 + F.lane * 8);
        u32x4 o; o.x = cvtpk(acc[0] * li * bflo(g.x), acc[1] * li * bfhi(g.x)); o.y = cvtpk(acc[2] * li * bflo(g.y), acc[3] * li * bfhi(g.y));
        o.z = cvtpk(acc[4] * li * bflo(g.z), acc[5] * li * bfhi(g.z)); o.w = cvtpk(acc[6] * li * bflo(g.w), acc[7] * li * bfhi(g.w));
        *(u32x4*)(F.AB + (size_t)row * DM + 512 + F.lane * 8) = o;
    }
}

constexpr int N_PHASES = 6;
__global__ void __launch_bounds__(NTHR, 2) fwd_kernel(Args args) {
    extern __shared__ __attribute__((aligned(16))) unsigned char lds_raw[];
    Frame F;
    F.lds = (LAS unsigned char*)lds_raw;
    F.tid = threadIdx.x; F.lane = F.tid & 63; F.wave = __builtin_amdgcn_readfirstlane(F.tid >> 6); F.G = gridDim.x; F.blk = blockIdx.x;
    unsigned char* ws = args.ws;
    F.xp = args.in[0]; F.xs = args.in[1]; F.ca = args.in[2]; F.cb1 = args.in[3]; F.cb2 = args.in[4]; F.cb3 = args.in[5]; F.relb = args.in[6]; F.ng = args.in[7]; F.win = args.in[8];
    F.qga = args.in[9]; F.kga = args.in[10]; F.snk = args.in[11]; F.qgb = args.in[12]; F.kgb = args.in[13]; F.wua = args.in[14]; F.wub = args.in[15]; F.wout = args.in[16]; F.out = args.out;
    F.WIN = (bf16*)(ws + WS_WIN); F.WUP = (bf16*)(ws + WS_WUP); F.WOUT = (bf16*)(ws + WS_WOUT); F.HB = (bf16*)(ws + WS_HB); F.Q = (bf16*)(ws + WS_Q); F.KA = (bf16*)(ws + WS_KA); F.VA = (bf16*)(ws + WS_VA);
    F.KB = (bf16*)(ws + WS_KB); F.VB = (bf16*)(ws + WS_VB); F.Gt = (bf16*)(ws + WS_G); F.OG = (bf16*)(ws + WS_OG); F.LG = (float*)(ws + WS_LG); F.AB = (bf16*)(ws + WS_AB); F.T = (bf16*)(ws + WS_T); F.MG = (bf16*)(ws + WS_MG);
    for (int u = F.tid; u < (LDS_BYTES - LDSCTL_OFF) / 4; u += NTHR) ((LAS unsigned*)(F.lds + LDSCTL_OFF))[u] = 0u;
    __syncthreads();
    volatile LAS unsigned* MISC = (volatile LAS unsigned*)(F.lds + MISC_OFF);
    const int lo = args.ph_lo, hi = args.ph_hi;
    XcdBarrier bar; bar.bar = (unsigned*)(ws + WS_CTL) + CW_BAR; bar.x = 0; bar.st = nullptr;
    if (hi - lo > 1) bar = xcd_barrier_post((unsigned*)(ws + WS_CTL) + CW_BAR, MISC + 8);
#define IN(k) (lo <= (k) && (k) < hi)
#define BOTH(k) (IN(k) && IN((k) + 1))
    if (IN(0)) { p0_prologue(F); if (BOTH(0)) xcd_barrier(bar); }
    if (IN(1)) {
        SchedP1 S; S.o.init(MR, CIN, F.G, F.blk); S.A = F.HB; S.B = F.WIN;
        EpiP1 E{F.Q, F.KA, F.VA, F.KB, F.VB, F.Gt, F.out, F.qga, F.kga, F.qgb, F.kgb};
        pg8::gemm_phase<EpiP1, SchedP1, true, true>(F.lds, DM, DM, DM, S, E);
        if (BOTH(1)) xcd_barrier(bar);
    }
    if (IN(2)) { p2_attention(F); if (BOTH(2)) xcd_barrier(bar); }
    if (IN(3)) { p2b_combine(F); if (BOTH(3)) xcd_barrier(bar); }
    if (IN(4)) {
        SchedP3 S; S.o.init(MR, DM, F.G, F.blk); S.A = F.AB; S.B = F.WUP;
        EpiP3 E{F.Gt, F.T, F.MG};
        pg8::gemm_phase<EpiP3, SchedP3, true, true>(F.lds, 512, DM, DM, S, E);
        if (BOTH(4)) xcd_barrier(bar);
    }
    if (IN(5)) {
        SchedP4 S; S.o.init(MR, DM, F.G, F.blk); S.A = F.MG; S.B = F.WOUT;
        EpiP4 E{F.xp, F.xs, F.out};
        pg8::gemm_phase<EpiP4, SchedP4, true, false>(F.lds, DM, DM, DM, S, E);
    }
#undef IN
#undef BOTH
}

extern "C" void kernel_launch(void* const* d_in, const int* in_sizes, int n_in, void* d_out, int out_size, void* d_ws, size_t ws_size, hipStream_t stream) {
    static int grid = 0;
    if (grid == 0) {
        if (n_in != 17 || out_size != (int)OUT_END || ws_size < WS_END) { fprintf(stderr, "kernel_launch: unexpected shapes (n_in %d out %d ws %zu)\n", n_in, out_size, ws_size); grid = -1; return; }
        int dev = 0, cus = 0, per_cu = 0;
        if (hipGetDevice(&dev) != hipSuccess || hipDeviceGetAttribute(&cus, hipDeviceAttributeMultiprocessorCount, dev) != hipSuccess) { grid = -1; return; }
        if (hipFuncSetAttribute((const void*)fwd_kernel, hipFuncAttributeMaxDynamicSharedMemorySize, LDS_BYTES) != hipSuccess) { fprintf(stderr, "kernel_launch: hipFuncSetAttribute failed\n"); grid = -1; return; }
        if (hipOccupancyMaxActiveBlocksPerMultiprocessor(&per_cu, (const void*)fwd_kernel, NTHR, LDS_BYTES) != hipSuccess || per_cu < 1) { fprintf(stderr, "kernel_launch: occupancy query says %d\n", per_cu); }
        (void)hipGetLastError();
        grid = cus;
    }
    if (grid < 0) return;
    (void)hipMemsetAsync((char*)d_ws + WS_CTL, 0, CTL_ZERO_BYTES, stream);
    Args a{};
    for (int i = 0; i < 17; ++i) a.in[i] = (const float*)d_in[i];
    a.out = (float*)d_out; a.ws = (unsigned char*)d_ws;
#if MK_N_LAUNCHES == 1
    a.ph_lo = 0; a.ph_hi = N_PHASES;
    hipLaunchKernelGGL(fwd_kernel, dim3(grid), dim3(NTHR), LDS_BYTES, stream, a);
#else
    for (int p = 0; p < N_PHASES; ++p) { a.ph_lo = p; a.ph_hi = p + 1; hipLaunchKernelGGL(fwd_kernel, dim3(grid), dim3(NTHR), LDS_BYTES, stream, a); }
#endif
}
```

```cpp
#include <hip/hip_runtime.h>
#include <cstdio>
#include <cstdint>

#ifndef MK_N_LAUNCHES
#define MK_N_LAUNCHES 1
#endif

#ifndef REP_P0
#define REP_P0 1
#define REP_P1 1
#define REP_P2 1
#define REP_P2B 1
#define REP_P3 1
#define REP_P4 1
#define REP_DEC 1
#define REP_ITEM 1
#define REP_EPI 1
#define PROBE_GRP -1
#define PROBE_LO -1
#define PROBE_HI -1
#endif
#define GAS __attribute__((address_space(1)))
#define LAS __attribute__((address_space(3)))
typedef unsigned short bf16;
typedef short bf16x8 __attribute__((ext_vector_type(8)));
typedef float f32x4 __attribute__((ext_vector_type(4)));
typedef float f32x2 __attribute__((ext_vector_type(2)));
typedef float f32x16 __attribute__((ext_vector_type(16)));
typedef unsigned u32x4 __attribute__((ext_vector_type(4)));
typedef unsigned u32x2 __attribute__((ext_vector_type(2)));
typedef short s16x4 __attribute__((ext_vector_type(4)));
typedef __bf16 bf16x2_t __attribute__((ext_vector_type(2)));

constexpr int DM = 1024, SEQ = 4096, NBATCH = 4, NP = NBATCH * SEQ, DECB = 128, DECT = 4, NSMP = DECB * DECT, MR = NP + NSMP, CIN = 8448;
constexpr int NWAVES = 8, NTHR = NWAVES * 64;
constexpr float LOG2E = 1.4426950408889634f;
constexpr float QSCALE = 0.125f * LOG2E;
constexpr float NEGBIG = -1.0e30f;
constexpr size_t OUT_YP = 0, OUT_YS = (size_t)NP * DM, OUT_PA = OUT_YS + (size_t)NSMP * DM, OUT_PB1 = OUT_PA + 4 * 128 * 2 * 2 * 64, OUT_PB2 = OUT_PB1 + 4 * 128 * 2 * 8 * 64,
                 OUT_PB3 = OUT_PB2 + 4 * 512 * 2 * 8 * 64, OUT_SA = OUT_PB3 + (size_t)4 * 2048 * 2 * 8 * 64, OUT_SB1 = OUT_SA + 128 * 4 * 2 * 2 * 64, OUT_SB2 = OUT_SB1 + 128 * 4 * 2 * 8 * 64,
                 OUT_SB3 = OUT_SB2 + 128 * 4 * 2 * 8 * 64, OUT_END = OUT_SB3 + 128 * 4 * 2 * 8 * 64;
static_assert(OUT_END == 30146560, "output size");
constexpr size_t MiB = 1u << 20;
constexpr size_t WS_CTL = 0, CTL_ZERO_BYTES = 64 * 1024;
constexpr size_t WS_WIN = 2 * MiB, WS_WUP = 20 * MiB, WS_WOUT = 22 * MiB, WS_HB = 32 * MiB, WS_Q = 72 * MiB, WS_KA = 140 * MiB, WS_VA = 146 * MiB, WS_KB = 152 * MiB, WS_VB = 204 * MiB,
                 WS_G = 256 * MiB, WS_OG = 360 * MiB, WS_LG = 412 * MiB, WS_AB = 416 * MiB, WS_T = 452 * MiB, WS_MG = 488 * MiB, WS_HB8 = 528 * MiB, WS_WIN8 = 548 * MiB, WS_AB8 = 560 * MiB, WS_MG8 = 576 * MiB, WS_WUP8 = 592 * MiB, WS_WOUT8 = 593 * MiB, WS_END = 594 * MiB;
constexpr int QP = 2048, KAP = 128, KBP = 1536, GP = 3072, OGP = 512;
constexpr int CW_BAR = 4096;
constexpr int RING_BYTES = 131072, LDSCTL_OFF = RING_BYTES, MISC_OFF = LDSCTL_OFF + 320, LDS_BYTES = 163840;
constexpr int AT_TAB = RING_BYTES + 1024, AT_TAB_BYTES = 32 * 192 * 4, AT_RED = AT_TAB + AT_TAB_BYTES, AT_LX = AT_RED + 256, AT_LSPAN = AT_LX + NWAVES * 128, AT_VT = 0, AT_ACC = NWAVES * 8192;
static_assert(AT_ACC + 512 * 128 <= RING_BYTES && AT_LSPAN + 512 * 4 <= LDS_BYTES && MISC_OFF + 128 <= AT_TAB, "attention LDS");

#define LDS_WAIT() asm volatile("s_waitcnt lgkmcnt(0)" ::: "memory")
#define VM_WAIT() asm volatile("s_waitcnt vmcnt(0)" ::: "memory")
#define RLX_AGENT __ATOMIC_RELAXED, __HIP_MEMORY_SCOPE_AGENT
__device__ __forceinline__ unsigned cvtpk(float lo, float hi) { f32x2 v = {lo, hi}; bf16x2_t b = __builtin_convertvector(v, bf16x2_t); return __builtin_bit_cast(unsigned, b); }
__device__ __forceinline__ float bflo(unsigned w) { return __builtin_bit_cast(float, w << 16); }
__device__ __forceinline__ float bfhi(unsigned w) { return __builtin_bit_cast(float, w & 0xffff0000u); }
__device__ __forceinline__ bool tile_fp8(int tile) { return tile < 2 || tile == 3 || tile == 4 || (tile >= 5 && tile < 11) || tile >= 23; }
__device__ __forceinline__ unsigned pk4_fp8(float a, float b, float c, float d) { int p = __builtin_amdgcn_cvt_pk_fp8_f32(a, b, 0, false); p = __builtin_amdgcn_cvt_pk_fp8_f32(c, d, p, true); return (unsigned)p; }
__device__ __forceinline__ float fexp2(float x) { return __builtin_amdgcn_exp2f(x); }

namespace pg8 {
constexpr int BM = 256, BK = 64, HALF = 128, HTB = HALF * BK * 2, STAGE_BYTES = 8 * HTB, NXCD = 8, WGM = 8;
__host__ __device__ __forceinline__ int lds_byte(int r, int c) { const int st = (r >> 4) * 2 + (c >> 5), rr = r & 15, cc = c & 31, ob = rr * 64 + cc * 2; return st * 1024 + (ob ^ (((ob >> 9) & 1) << 5)); }
__host__ __device__ __forceinline__ void stage_rc(int b, int& R, int& C) { const int st = b / 1024, sb = b % 1024, swz = sb ^ (((sb >> 9) & 1) << 5); R = (st >> 1) * 16 + swz / 64; C = (st & 1) * 32 + (swz % 64) / 2; }
__host__ __device__ __forceinline__ int perm32(int rho) { const int n = rho >> 4, i = rho & 15; return 8 * (i >> 2) + 4 * n + (i & 3); }
struct Unit { int pm, pn, kind, f8; };
struct TileOrder {
    int nM, nN, nwg, G, c;
    __device__ void init(int M, int N, int G_, int c_) { nM = M / BM; nN = N / BM; nwg = nM * nN; G = G_; c = c_; }
    __device__ bool tile(int i, int& pm, int& pn) const {
        const long L = (long)i * G + c; if (L >= nwg) return false;
        int wgid = (int)L; { const int q = nwg / NXCD, r = nwg % NXCD, xcd = wgid % NXCD, off = wgid / NXCD; wgid = (xcd < r ? xcd * (q + 1) : r * (q + 1) + (xcd - r) * q) + off; }
        const int nig = WGM * nN, gid = wgid / nig, fm = gid * WGM, gsz = (nM - fm) < WGM ? (nM - fm) : WGM;
        pm = fm + ((wgid % nig) % gsz); pn = (wgid % nig) / gsz; return true;
    }
};

typedef int i32x8 __attribute__((ext_vector_type(8)));
typedef int i32x4v __attribute__((ext_vector_type(4)));
__device__ __forceinline__ i32x8 cat8(bf16x8 x, bf16x8 y) { const i32x4v a = __builtin_bit_cast(i32x4v, x), b = __builtin_bit_cast(i32x4v, y); return __builtin_shufflevector(a, b, 0, 1, 2, 3, 4, 5, 6, 7); }
template <bool M> struct Frag;
template <> struct Frag<true>  { i32x8 v; __device__ __forceinline__ void set(bf16x8 l, bf16x8 h) { v = cat8(l, h); }
    __device__ __forceinline__ bf16x8 lo() const { return __builtin_bit_cast(bf16x8, __builtin_shufflevector(v, v, 0, 1, 2, 3)); } __device__ __forceinline__ bf16x8 hi() const { return __builtin_bit_cast(bf16x8, __builtin_shufflevector(v, v, 4, 5, 6, 7)); }
    __device__ __forceinline__ i32x8 all() const { return v; } };
template <> struct Frag<false> { bf16x8 a, b; __device__ __forceinline__ void set(bf16x8 l, bf16x8 h) { a = l; b = h; }
    __device__ __forceinline__ bf16x8 lo() const { return a; } __device__ __forceinline__ bf16x8 hi() const { return b; } __device__ __forceinline__ i32x8 all() const { return cat8(a, b); } };
template <class Epi, class Sched, bool ALIGN_EPI, bool PERM, bool F8, bool MIDHOOK = false>
__device__ __forceinline__ void gemm_phase(LAS unsigned char* lds, const int K, const Sched& S, const Epi& E) {
    const int tid = threadIdx.x, wid = __builtin_amdgcn_readfirstlane(tid >> 6), lane = tid & 63, wr = wid >> 2, wc = wid & 3, fr = lane & 15, fq = lane >> 4;
    constexpr int PITCH = F8 ? 1024 : 2048;
    unsigned voffA[2], voffB[2];
#pragma unroll
    for (int i = 0; i < 2; ++i) { int R, C; stage_rc(tid * 16 + i * 8192, R, C); const int Rb = PERM ? ((R & ~31) + perm32(R & 31)) : R;
        voffA[i] = (unsigned)(R * PITCH + C * 2); voffB[i] = (unsigned)(Rb * PITCH + C * 2); }
    const size_t kstep = (size_t)(BK * 2);
    const unsigned ldsw = (unsigned)wid * 1024u;
    const int aoff = lds_byte(wr * 64 + fr, fq * 8), boff = lds_byte(wc * 32 + fr, fq * 8);
#define PG8_SA(b, h) (((b) * 2 + (h)) * HTB)
#define PG8_SB(b, h) ((4 + (b) * 2 + (h)) * HTB)
#define PG8_STAGE(bufoff, gbase, v16, v8, f8) do { _Pragma("unroll") for (int _i = 0; _i < 2; ++_i) { const unsigned vo_ = (v16)[_i]; \
        __builtin_amdgcn_global_load_lds((const unsigned*)((const char*)(gbase) + vo_), (LAS unsigned*)(lds + (bufoff) + ldsw + _i * 8192), 16, 0, 0); } } while (0)
#define PG8_STA(bufoff, gbase, f8) PG8_STAGE(bufoff, gbase, voffA, voffA, f8)
#define PG8_STB(bufoff, gbase, f8) PG8_STAGE(bufoff, gbase, voffB, voffB, f8)
#define PG8_HS(f8) ((size_t)HALF * PITCH)
#define PG8_LDA(dst, b, h) do { _Pragma("unroll") for (int m = 0; m < 4; ++m) dst[m].set(*(const LAS bf16x8*)(lds + PG8_SA(b, h) + aoff + m * 2048), *(const LAS bf16x8*)(lds + PG8_SA(b, h) + aoff + m * 2048 + 1024)); } while (0)
#define PG8_LDB(dst, b, h) do { _Pragma("unroll") for (int n = 0; n < 2; ++n) dst[n].set(*(const LAS bf16x8*)(lds + PG8_SB(b, h) + boff + n * 2048), *(const LAS bf16x8*)(lds + PG8_SB(b, h) + boff + n * 2048 + 1024)); } while (0)
#define PG8_LO(x) (x).lo()
#define PG8_HI(x) (x).hi()
#define PG8_MMA16(ai, bj, At, Bt) do { __builtin_amdgcn_s_setprio(1); _Pragma("unroll") for (int m = 0; m < 4; ++m) _Pragma("unroll") for (int n = 0; n < 2; ++n) { \
            acc[ai][bj][m][n] = __builtin_amdgcn_mfma_f32_16x16x32_bf16(PG8_LO(Bt[n]), PG8_LO(At[m]), acc[ai][bj][m][n], 0, 0, 0); \
            acc[ai][bj][m][n] = __builtin_amdgcn_mfma_f32_16x16x32_bf16(PG8_HI(Bt[n]), PG8_HI(At[m]), acc[ai][bj][m][n], 0, 0, 0); } \
        __builtin_amdgcn_s_setprio(0); } while (0)
#define PG8_MMA8(ai, bj, At, Bt) do { __builtin_amdgcn_s_setprio(1); _Pragma("unroll") for (int m = 0; m < 4; ++m) _Pragma("unroll") for (int n = 0; n < 2; ++n) \
            asm volatile("v_mfma_scale_f32_16x16x128_f8f6f4 %0, %1, %2, %0, %3, %4 op_sel_hi:[0,0,0]" : "+v"(acc[ai][bj][m][n]) : "v"(Bt[n].all()), "v"(At[m].all()), "v"(sc_w), "v"(sc_a)); \
        __builtin_amdgcn_s_setprio(0); } while (0)
#define PG8_WAIT_V(n) asm volatile("s_waitcnt vmcnt(" #n ")" ::: "memory")
#define PG8_WAIT_L(n) asm volatile("s_waitcnt lgkmcnt(" #n ")" ::: "memory")
#define PG8_BAR __builtin_amdgcn_s_barrier()
#define PG8_SCHED __builtin_amdgcn_sched_barrier(0)
    Unit cur, nxt; int ui = 0;
    if (!S.next(0, cur)) return;
    f32x4 acc[2][2][4][2];
#pragma unroll
    for (int a = 0; a < 2; ++a)
#pragma unroll
        for (int b = 0; b < 2; ++b)
#pragma unroll
            for (int m = 0; m < 4; ++m)
#pragma unroll
                for (int n = 0; n < 2; ++n) acc[a][b][m][n] = (f32x4){0.f, 0.f, 0.f, 0.f};
    Frag<F8> At[4], B0[2], B1[2];
    const int sc_w = S.scw, sc_a = S.sca;
    const char* cA; const char* cB; S.ptrs(cur, cA, cB);
    constexpr bool cf8 = F8;
    PG8_STB(PG8_SB(0, 0), cB, cf8); PG8_STB(PG8_SB(0, 1), cB + PG8_HS(cf8), cf8); PG8_STA(PG8_SA(0, 0), cA, cf8); PG8_STA(PG8_SA(0, 1), cA + PG8_HS(cf8), cf8);
    if (wr == 1) PG8_BAR;
    PG8_WAIT_V(2); PG8_BAR;
    PG8_STB(PG8_SB(1, 0), cB + kstep, cf8); PG8_STA(PG8_SA(1, 0), cA + kstep, cf8); PG8_STB(PG8_SB(1, 1), cB + PG8_HS(cf8) + kstep, cf8);
    PG8_WAIT_V(6); PG8_BAR;
    for (;;) {
        const bool has_next = S.next(ui + 1, nxt);
        const char* nA = cA; const char* nB = cB; if (has_next) S.ptrs(nxt, nA, nB);
        constexpr bool nf8 = F8;
        const int nt = F8 ? K / 128 : K / BK;
#define PG8_KLOOP(MMA, T0, T1) _Pragma("nounroll") for (int t = (T0); t < (T1); t += 2) { \
            const bool last = (t == nt - 2); \
            const bool f2 = last ? nf8 : cf8;                     \
            const char* a1 = cA + (size_t)(t + 1) * kstep; \
            const char* a2 = last ? nA : cA + (size_t)(t + 2) * kstep; const char* b2 = last ? nB : cB + (size_t)(t + 2) * kstep; \
            const char* a3 = a2 + kstep; const char* b3 = b2 + kstep; \
            PG8_LDB(B0, 0, 0); PG8_LDB(B1, 0, 1); PG8_SCHED; PG8_LDA(At, 0, 0); PG8_STA(PG8_SA(1, 1), a1 + PG8_HS(cf8), cf8); \
            PG8_WAIT_V(8); PG8_WAIT_L(0); PG8_BAR; MMA(0, 0, At, B0); MMA(0, 1, At, B1); PG8_BAR; PG8_SCHED; \
            PG8_LDA(At, 0, 1); PG8_STB(PG8_SB(0, 0), b2, f2); PG8_STB(PG8_SB(0, 1), b2 + PG8_HS(f2), f2); PG8_STA(PG8_SA(0, 0), a2, f2); \
            PG8_WAIT_V(8); PG8_WAIT_L(0); PG8_BAR; MMA(1, 0, At, B0); MMA(1, 1, At, B1); PG8_BAR; PG8_SCHED; \
            PG8_LDB(B0, 1, 0); PG8_LDB(B1, 1, 1); PG8_SCHED; PG8_LDA(At, 1, 0); PG8_STA(PG8_SA(0, 1), a2 + PG8_HS(f2), f2); \
            PG8_WAIT_V(8); PG8_WAIT_L(0); PG8_BAR; MMA(0, 0, At, B0); MMA(0, 1, At, B1); PG8_BAR; PG8_SCHED; \
            PG8_LDA(At, 1, 1); PG8_STB(PG8_SB(1, 0), b3, f2); PG8_STB(PG8_SB(1, 1), b3 + PG8_HS(f2), f2); PG8_STA(PG8_SA(1, 0), a3, f2); \
            PG8_WAIT_V(8); PG8_WAIT_L(0); PG8_BAR; MMA(1, 0, At, B0); MMA(1, 1, At, B1); PG8_BAR; PG8_SCHED; \
        }
        if constexpr (F8 && MIDHOOK) {
            PG8_KLOOP(PG8_MMA8, 0, nt / 2) asm volatile("s_nop 15\n\ts_nop 7" ::: "memory");
            E.mid(acc, cur, wr, wc, fr, fq);
            PG8_KLOOP(PG8_MMA8, nt / 2, nt) asm volatile("s_nop 15\n\ts_nop 7" ::: "memory");
        } else if constexpr (F8) { PG8_KLOOP(PG8_MMA8, 0, nt) asm volatile("s_nop 15\n\ts_nop 7" ::: "memory");   }
        else { PG8_KLOOP(PG8_MMA16, 0, nt) }
#undef PG8_KLOOP
        if constexpr (ALIGN_EPI) { if (wr == 0) PG8_BAR; }
        E(acc, cur, wr, wc, fr, fq);
#if REP_EPI > 1
        asm volatile("" ::: "memory"); E(acc, cur, wr, wc, fr, fq);
#endif
        if (!has_next) break;
#pragma unroll
        for (int a = 0; a < 2; ++a)
#pragma unroll
            for (int b = 0; b < 2; ++b)
#pragma unroll
                for (int m = 0; m < 4; ++m)
#pragma unroll
                    for (int n = 0; n < 2; ++n) acc[a][b][m][n] = (f32x4){0.f, 0.f, 0.f, 0.f};
        cur = nxt; cA = nA; cB = nB; ++ui;
        if constexpr (ALIGN_EPI) { if (wr == 1) PG8_BAR; }
    }
    PG8_WAIT_V(0);
    if constexpr (!ALIGN_EPI) { if (wr == 0) PG8_BAR; }
    PG8_BAR;
#undef PG8_SA
#undef PG8_SB
#undef PG8_STAGE
#undef PG8_STA
#undef PG8_STB
#undef PG8_HS
#undef PG8_LDA
#undef PG8_LDB
#undef PG8_LO
#undef PG8_HI
#undef PG8_MMA16
#undef PG8_MMA8
#undef PG8_WAIT_V
#undef PG8_WAIT_L
#undef PG8_BAR
#undef PG8_SCHED
}
}

#define XB_TMO      128
#define XB_XCNT(j)  (256  + 64 * (j))
#define XB_XSUB(j)  (1280 + 64 * (j))
#define XB_XGEN(j)  (2304 + 64 * (j))
#define XB_TOP      3328
#define XB_TOPGEN   3392
#define XCD_BAR_WORDS 3456
#define XB_SPIN_CAP (1u << 18)
__device__ __forceinline__ unsigned xb_ld(unsigned* p)              { return __hip_atomic_load(p, __ATOMIC_RELAXED, __HIP_MEMORY_SCOPE_AGENT); }
__device__ __forceinline__ unsigned xb_add(unsigned* p, unsigned v) { return __hip_atomic_fetch_add(p, v, __ATOMIC_RELAXED, __HIP_MEMORY_SCOPE_AGENT); }
__device__ __forceinline__ unsigned xb_xcc_id() { return (unsigned)__builtin_amdgcn_s_getreg((3 << 11) | 20) & 0xFu; }
#define XB_SPIN(cond, bar) do { unsigned _sp = 0; while (cond) { __builtin_amdgcn_s_sleep(1); \
    if ((++_sp & 255u) == 0u) { if (xb_ld(&(bar)[XB_TMO])) break; if (_sp > XB_SPIN_CAP) { atomicAdd(&(bar)[XB_TMO], 1u); break; } } } } while (0)
struct XcdBarrier { unsigned* bar; unsigned x; volatile LAS unsigned* st; };
__device__ __forceinline__ XcdBarrier xcd_barrier_post(unsigned* bar, volatile LAS unsigned* st) {
    XcdBarrier b; b.bar = bar; b.x = xb_xcc_id(); b.st = st;
    if (threadIdx.x == 0) (void)xb_add(&bar[XB_XCNT(b.x)], 1u);
    return b;
}
__device__ __forceinline__ void xcd_barrier_complete(unsigned* bar, unsigned x, unsigned& nloc, unsigned& nx) {
    const unsigned G = gridDim.x * gridDim.y * gridDim.z;
    unsigned sum, cnt, mine, sp = 0u;
    for (;;) {
        sum = 0u; cnt = 0u; mine = 0u;
#pragma unroll
        for (unsigned j = 0; j < 16; ++j) { const unsigned c = xb_ld(&bar[XB_XCNT(j)]); sum += c; cnt += (c > 0u) ? 1u : 0u; mine = (j == x) ? c : mine; }
        if (sum == G) break;
        __builtin_amdgcn_s_sleep(1);
        if ((++sp & 255u) == 0u) { if (xb_ld(&bar[XB_TMO])) break; if (sp > XB_SPIN_CAP) { atomicAdd(&bar[XB_TMO], 1u); break; } }
    }
    nloc = mine > 0u ? mine : 1u; nx = cnt > 0u ? cnt : 1u;
}
__device__ __forceinline__ void xcd_barrier(const XcdBarrier& b) {
    asm volatile("s_waitcnt vmcnt(0)" ::: "memory");
    __syncthreads();
    if (threadIdx.x == 0) {
        unsigned* bar = b.bar;
        __builtin_amdgcn_s_waitcnt(0);
        unsigned nloc = b.st[0], nx = b.st[1];
        if (nloc == 0u) { xcd_barrier_complete(bar, b.x, nloc, nx); b.st[0] = nloc; b.st[1] = nx; }
        const unsigned old = xb_add(&bar[XB_XSUB(b.x)], 1u);
        const unsigned gen = old / nloc;
        if (old + 1u == (gen + 1u) * nloc) {
            __builtin_amdgcn_fence(__ATOMIC_RELEASE, "agent");
            asm volatile("s_waitcnt vmcnt(0)" ::: "memory");
            const unsigned og = xb_add(&bar[XB_TOP], 1u);
            const unsigned tg = og / nx;
            if (og + 1u == (tg + 1u) * nx) xb_add(&bar[XB_TOPGEN], 1u);
            else XB_SPIN(xb_ld(&bar[XB_TOPGEN]) == tg, bar);
            __builtin_amdgcn_fence(__ATOMIC_ACQUIRE, "agent");
            xb_add(&bar[XB_XGEN(b.x)], 1u);
            asm volatile("s_waitcnt vmcnt(0)" ::: "memory");
        } else {
            XB_SPIN(xb_ld(&bar[XB_XGEN(b.x)]) == gen, bar);
            __builtin_amdgcn_fence(__ATOMIC_ACQUIRE, "agent");
            asm volatile("s_waitcnt vmcnt(0)" ::: "memory");
        }
    }
    __syncthreads();
}

struct Args { const float* in[17]; float* out; unsigned char* ws; int ph_lo, ph_hi; };
struct Frame {
    LAS unsigned char* lds;
    int tid, lane, wave, G, blk;
    const float *xp, *xs, *ca, *cb1, *cb2, *cb3, *relb, *ng, *win, *qga, *kga, *snk, *qgb, *kgb, *wua, *wub, *wout;
    float* out;
    unsigned char *HB8, *WIN8, *AB8, *MG8, *WUP8, *WOUT8; bf16 *WIN, *WUP, *WOUT, *HB, *Q, *KA, *VA, *KB, *VB, *Gt, *OG, *AB, *T, *MG;
    float* LG;
};
__device__ __forceinline__ float wave_sum(float v) {
#pragma unroll
    for (int o = 1; o < 64; o <<= 1) v += __shfl_xor(v, o);
    return v;
}
__device__ __forceinline__ float wave_max(float v) {
#pragma unroll
    for (int o = 1; o < 64; o <<= 1) v = fmaxf(v, __shfl_xor(v, o));
    return v;
}

__device__ __forceinline__ void p0_transpose_item(const float* W, int N, bf16* WT, int ldo, int koff, int rowbase, int k0, int n0, LAS float* scr, int lane, unsigned char* WT8 = nullptr, bool both = false) {
    float tv[32];
#pragma unroll
    for (int i = 0; i < 32; ++i) { const int kk = 2 * i + (lane >> 5); tv[i] = W[(size_t)(k0 + kk) * N + n0 + (lane & 31)]; }
#pragma unroll
    for (int i = 0; i < 32; ++i) { const int kk = 2 * i + (lane >> 5); scr[kk * 33 + (lane & 31)] = tv[i]; }
    LDS_WAIT(); asm volatile("" ::: "memory");
    const int c = lane & 7;
#pragma unroll
    for (int j = 0; j < 4; ++j) { const int n = (lane >> 3) + 8 * j; const LAS float* s = scr + (8 * c) * 33 + n;
        if (WT8) {
            u32x2 o8; o8.x = pk4_fp8(s[0 * 33] * 32.f, s[1 * 33] * 32.f, s[2 * 33] * 32.f, s[3 * 33] * 32.f); o8.y = pk4_fp8(s[4 * 33] * 32.f, s[5 * 33] * 32.f, s[6 * 33] * 32.f, s[7 * 33] * 32.f);
            *(u32x2*)(WT8 + (size_t)(rowbase + n) * 1024 + koff + k0 + 8 * c) = o8;
        }
        if (!WT8 || both) {
        u32x4 o; o.x = cvtpk(s[0 * 33], s[1 * 33]); o.y = cvtpk(s[2 * 33], s[3 * 33]); o.z = cvtpk(s[4 * 33], s[5 * 33]); o.w = cvtpk(s[6 * 33], s[7 * 33]);
        *(u32x4*)(WT + (size_t)(rowbase + n) * ldo + koff + k0 + 8 * c) = o; } }
    LDS_WAIT(); asm volatile("" ::: "memory");
}
__device__ __forceinline__ void p0_prologue(Frame& F) {
    LAS float* scr = (LAS float*)(F.lds + F.wave * 16384);
    const int gw = F.blk * NWAVES + F.wave, NGW = F.G * NWAVES;
    constexpr int I_IN = (DM / 64) * (CIN / 32), I_UP = (512 / 64) * (DM / 32), I_OUT = (DM / 64) * (DM / 32);
    constexpr int NITEMS = I_IN + 2 * I_UP + I_OUT;
    for (int it = gw; it < NITEMS; it += NGW) {
        int r = it;
        if (r < I_IN) { const int nblk = CIN / 32, kb = r / nblk, nb = r % nblk, n0 = 32 * nb;
            const int rb = (n0 & ~255) + 128 * ((n0 >> 5) & 1) + 32 * ((n0 >> 6) & 3);
            p0_transpose_item(F.win, CIN, F.WIN, DM, 0, rb, 64 * kb, n0, scr, F.lane, tile_fp8(n0 >> 8) ? F.WIN8 : nullptr); continue; }
        r -= I_IN;
        if (r < I_UP) { const int nblk = DM / 32, kb = r / nblk, nb = r % nblk; p0_transpose_item(F.wua, DM, F.WUP, DM, 0, 32 * nb, 64 * kb, 32 * nb, scr, F.lane, F.WUP8, true); continue; }
        r -= I_UP;
        if (r < I_UP) { const int nblk = DM / 32, kb = r / nblk, nb = r % nblk; p0_transpose_item(F.wub, DM, F.WUP, DM, 512, 32 * nb, 64 * kb, 32 * nb, scr, F.lane, F.WUP8, true); continue; }
        r -= I_UP;
        { const int nblk = DM / 32, kb = r / nblk, nb = r % nblk; p0_transpose_item(F.wout, DM, F.WOUT, DM, 0, 32 * nb, 64 * kb, 32 * nb, scr, F.lane, F.WOUT8, true); }
    }
    f32x4 gv[4];
#pragma unroll
    for (int j = 0; j < 4; ++j) gv[j] = *((const f32x4*)F.ng + F.lane + 64 * j);
    for (int m0 = gw; m0 < MR; m0 += 3 * NGW) {
        f32x4 v[3][4];
#pragma unroll
        for (int u = 0; u < 3; ++u) { const int m = m0 + u * NGW; if (m < MR) {
            const float* xrow = (m < NP) ? F.xp + (size_t)m * DM : F.xs + (size_t)(m - NP) * DM;
            const f32x4* xr = (const f32x4*)xrow + F.lane;
#pragma unroll
            for (int j = 0; j < 4; ++j) v[u][j] = xr[64 * j]; } }
#pragma unroll
        for (int u = 0; u < 3; ++u) { const int m = m0 + u * NGW; if (m < MR) {
            float s = 0.f;
#pragma unroll
            for (int j = 0; j < 4; ++j) s += (v[u][j].x * v[u][j].x + v[u][j].y * v[u][j].y) + (v[u][j].z * v[u][j].z + v[u][j].w * v[u][j].w);
            const float rs = 1.0f / sqrtf(wave_sum(s) * (1.f / DM) + 1e-6f);
            unsigned long long* o8 = (unsigned long long*)(F.HB + (size_t)m * DM) + F.lane;
#pragma unroll
            for (int j = 0; j < 4; ++j) { const f32x4 w = v[u][j] * rs * gv[j]; o8[64 * j] = (unsigned long long)cvtpk(w.x, w.y) | ((unsigned long long)cvtpk(w.z, w.w) << 32); }
            unsigned* p8 = (unsigned*)(F.HB8 + (size_t)m * DM) + F.lane;
#pragma unroll
            for (int j = 0; j < 4; ++j) { const f32x4 w = v[u][j] * rs * gv[j]; p8[64 * j] = pk4_fp8(w.x, w.y, w.z, w.w); } } }
    }
}

struct SchedP1 {
    pg8::TileOrder o; int cls; const char* A; const char* B; int scw, sca;
    __device__ void init(int G, int c, int cls_) { cls = cls_; scw = 0x7A7A7A7A; sca = 0x7F7F7F7F;
        o.init(MR, (cls_ == 0 ? 13 : 10) * 256, G, cls_ == 1 ? G - 1 - c : c); }
    __device__ __forceinline__ bool next(int i, pg8::Unit& u) const {
        u.kind = 0; u.f8 = (cls != 0); int pn; const bool ok = o.tile(i, u.pm, pn);
        u.pn = (cls == 0) ? ((pn == 0) ? 2 : 10 + pn) : (cls == 1 ? (pn < 2 ? pn : pn + 1) : 23 + pn); return ok;
    }
    __device__ __forceinline__ void ptrs(const pg8::Unit& u, const char*& a, const char*& b) const {
        const size_t tb = (cls != 0) ? (size_t)256 * 1024 : (size_t)256 * 2048;
        a = A + (size_t)u.pm * tb; b = B + (size_t)u.pn * tb;
    }
};
struct EpiP1 {
    bf16 *Q, *KA, *VA, *KB, *VB, *Gt; float* out; const float *qga, *kga, *qgb, *kgb;
    __device__ __forceinline__ void operator()(const f32x4 (&acc)[2][2][4][2], const pg8::Unit& u, int wr, int wc, int fr, int fq) const {
        const int pn = u.pn;
        int mode, pitch, col, ogrp = -1, okv = 0, ohead = 0; bf16* dst; const float* gain = nullptr; float scale = 1.f;
        if (pn < 2) { mode = 0; dst = Q; pitch = QP; col = 256 * pn + 64 * wc; gain = qga; scale = QSCALE; }
        else if (pn == 2) { if (wc < 2) { mode = 0; dst = KA; pitch = KAP; col = 64 * wc; gain = kga; ogrp = 0; okv = 0; ohead = wc; }
                            else { mode = 1; dst = VA; pitch = KAP; col = 64 * (wc - 2); ogrp = 0; okv = 1; ohead = wc - 2; } }
        else if (pn < 5) { mode = 2; dst = Gt; pitch = GP; col = 256 * (pn - 3) + 64 * wc; }
        else if (pn < 11) { mode = 0; dst = Q; pitch = QP; col = 512 + 256 * (pn - 5) + 64 * wc; gain = qgb + 64 * ((pn - 5) >> 1); scale = QSCALE; }
        else if (pn < 17) { const int g = (pn - 11) >> 1; mode = 0; dst = KB; pitch = KBP; col = 256 * (pn - 11) + 64 * wc; gain = kgb + 64 * g; ogrp = 1 + g; okv = 0; ohead = 4 * ((pn - 11) & 1) + wc; }
        else if (pn < 23) { const int g = (pn - 17) >> 1; mode = 1; dst = VB; pitch = KBP; col = 256 * (pn - 17) + 64 * wc; ogrp = 1 + g; okv = 1; ohead = 4 * ((pn - 17) & 1) + wc; }
        else if (pn < 25) { mode = 2; dst = Gt; pitch = GP; col = 512 + 256 * (pn - 23) + 64 * wc; }
        else { mode = 3; dst = Gt; pitch = GP; col = 1024 + 256 * (pn - 25) + 64 * wc; }
        float gvv[16];
        if (mode == 0) {
#pragma unroll
            for (int bj = 0; bj < 2; ++bj) { const f32x4 g0 = *(const f32x4*)(gain + 32 * bj + 8 * fq), g1 = *(const f32x4*)(gain + 32 * bj + 8 * fq + 4);
                gvv[bj * 8 + 0] = g0.x * scale; gvv[bj * 8 + 1] = g0.y * scale; gvv[bj * 8 + 2] = g0.z * scale; gvv[bj * 8 + 3] = g0.w * scale;
                gvv[bj * 8 + 4] = g1.x * scale; gvv[bj * 8 + 5] = g1.y * scale; gvv[bj * 8 + 6] = g1.z * scale; gvv[bj * 8 + 7] = g1.w * scale; }
        }
        const int W = (ogrp <= 1) ? 128 : (ogrp == 2 ? 512 : 2048), H = (ogrp == 0) ? 2 : 8;
        const size_t obp = (ogrp == 0) ? OUT_PA : (ogrp == 1) ? OUT_PB1 : (ogrp == 2) ? OUT_PB2 : OUT_PB3;
        const size_t obs = (ogrp == 0) ? OUT_SA : (ogrp == 1) ? OUT_SB1 : (ogrp == 2) ? OUT_SB2 : OUT_SB3;
#pragma unroll
        for (int ai = 0; ai < 2; ++ai)
#pragma unroll
            for (int m = 0; m < 4; ++m) {
                const int row = u.pm * 256 + ai * 128 + wr * 64 + m * 16 + fr;
                float v[16];
#pragma unroll
                for (int bj = 0; bj < 2; ++bj)
#pragma unroll
                    for (int n = 0; n < 2; ++n) { const f32x4 a = acc[ai][bj][m][n]; v[bj * 8 + n * 4 + 0] = a.x; v[bj * 8 + n * 4 + 1] = a.y; v[bj * 8 + n * 4 + 2] = a.z; v[bj * 8 + n * 4 + 3] = a.w; }
                if (mode == 0) {
                    float ss = 0.f;
#pragma unroll
                    for (int e = 0; e < 16; ++e) ss += v[e] * v[e];
                    ss += __shfl_xor(ss, 16); ss += __shfl_xor(ss, 32);
                    const float rinv = __builtin_amdgcn_rsqf(ss * (1.f / 64.f) + 1e-6f);
#pragma unroll
                    for (int e = 0; e < 16; ++e) v[e] = v[e] * rinv * gvv[e];
                } else if (mode == 2) {
#pragma unroll
                    for (int e = 0; e < 16; ++e) v[e] = v[e] * __builtin_amdgcn_rcpf(1.f + fexp2(-LOG2E * v[e]));
                } else if (mode == 3) {
#pragma unroll
                    for (int e = 0; e < 16; ++e) v[e] = __builtin_amdgcn_rcpf(1.f + fexp2(-LOG2E * v[e]));
                }
                {
                    u32x4 w0, w1;
                    w0.x = cvtpk(v[0], v[1]); w0.y = cvtpk(v[2], v[3]); w0.z = cvtpk(v[4], v[5]); w0.w = cvtpk(v[6], v[7]);
                    w1.x = cvtpk(v[8], v[9]); w1.y = cvtpk(v[10], v[11]); w1.z = cvtpk(v[12], v[13]); w1.w = cvtpk(v[14], v[15]);
                    const bool lo8 = fr < 8;
                    const u32x4 snd = lo8 ? w1 : w0; u32x4 rcv;
                    rcv.x = (unsigned)__builtin_amdgcn_update_dpp(0, (int)snd.x, 0x128, 0xF, 0xF, true); rcv.y = (unsigned)__builtin_amdgcn_update_dpp(0, (int)snd.y, 0x128, 0xF, 0xF, true);
                    rcv.z = (unsigned)__builtin_amdgcn_update_dpp(0, (int)snd.z, 0x128, 0xF, 0xF, true); rcv.w = (unsigned)__builtin_amdgcn_update_dpp(0, (int)snd.w, 0x128, 0xF, 0xF, true);
                    const u32x4 dA = lo8 ? w0 : rcv, dB = lo8 ? rcv : w1;
                    const int rowA = row - (fr & 8);
                    bf16* pA = dst + (size_t)rowA * pitch + col + 32 * (fr >> 3) + 8 * fq;
                    *(u32x4*)pA = dA; *(u32x4*)(pA + (size_t)8 * pitch) = dB;
                }
                if (ogrp >= 0) {
                    float* o = nullptr;
                    if (row < NP) { const int b = row >> 12, t = row & 4095; if (t >= SEQ - W) o = out + obp + ((size_t)((b * W + t - (SEQ - W)) * 2 + okv) * H + ohead) * 64; }
                    else { const int rs = row - NP; o = out + obs + ((size_t)(rs * 2 + okv) * H + ohead) * 64; }
                    if (o) {
#pragma unroll
                        for (int bj = 0; bj < 2; ++bj) { *(f32x4*)(o + 32 * bj + 8 * fq) = (f32x4){v[bj * 8 + 0], v[bj * 8 + 1], v[bj * 8 + 2], v[bj * 8 + 3]};
                            *(f32x4*)(o + 32 * bj + 8 * fq + 4) = (f32x4){v[bj * 8 + 4], v[bj * 8 + 5], v[bj * 8 + 6], v[bj * 8 + 7]}; }
                    }
                }
            }
    }
};

struct EpiP1F8 {
    bf16 *Q, *Gt; const float *qga, *qgb;
    __device__ __forceinline__ void operator()(const f32x4 (&acc)[2][2][4][2], const pg8::Unit& u, int wr, int wc, int fr, int fq) const {
        const int pn = u.pn;
        int mode, pitch, col; bf16* dst; const float* gain = qga;
        if (pn < 2) { mode = 0; dst = Q; pitch = QP; col = 256 * pn + 64 * wc; }
        else if (pn < 5) { mode = 2; dst = Gt; pitch = GP; col = 256 * (pn - 3) + 64 * wc; }
        else if (pn < 11) { mode = 0; dst = Q; pitch = QP; col = 512 + 256 * (pn - 5) + 64 * wc; gain = qgb + 64 * ((pn - 5) >> 1); }
        else if (pn < 25) { mode = 2; dst = Gt; pitch = GP; col = 512 + 256 * (pn - 23) + 64 * wc; }
        else { mode = 3; dst = Gt; pitch = GP; col = 1024 + 256 * (pn - 25) + 64 * wc; }
        float gvv[16];
        if (mode == 0) {
#pragma unroll
            for (int bj = 0; bj < 2; ++bj) { const f32x4 g0 = *(const f32x4*)(gain + 32 * bj + 8 * fq), g1 = *(const f32x4*)(gain + 32 * bj + 8 * fq + 4);
                gvv[bj * 8 + 0] = g0.x * QSCALE; gvv[bj * 8 + 1] = g0.y * QSCALE; gvv[bj * 8 + 2] = g0.z * QSCALE; gvv[bj * 8 + 3] = g0.w * QSCALE;
                gvv[bj * 8 + 4] = g1.x * QSCALE; gvv[bj * 8 + 5] = g1.y * QSCALE; gvv[bj * 8 + 6] = g1.z * QSCALE; gvv[bj * 8 + 7] = g1.w * QSCALE; }
        }
#pragma unroll
        for (int ai = 0; ai < 2; ++ai)
#pragma unroll
            for (int m = 0; m < 4; ++m) {
                const int row = u.pm * 256 + ai * 128 + wr * 64 + m * 16 + fr;
                float v[16];
#pragma unroll
                for (int bj = 0; bj < 2; ++bj)
#pragma unroll
                    for (int n = 0; n < 2; ++n) { const f32x4 a = acc[ai][bj][m][n]; v[bj * 8 + n * 4 + 0] = a.x; v[bj * 8 + n * 4 + 1] = a.y; v[bj * 8 + n * 4 + 2] = a.z; v[bj * 8 + n * 4 + 3] = a.w; }
                if (mode == 0) {
                    float ss = 0.f;
#pragma unroll
                    for (int e = 0; e < 16; ++e) ss += v[e] * v[e];
                    ss += __shfl_xor(ss, 16); ss += __shfl_xor(ss, 32);
                    const float rinv = __builtin_amdgcn_rsqf(ss * (1.f / 64.f) + 1e-6f);
#pragma unroll
                    for (int e = 0; e < 16; ++e) v[e] = v[e] * rinv * gvv[e];
                } else if (mode == 2) {
#pragma unroll
                    for (int e = 0; e < 16; ++e) v[e] = v[e] * __builtin_amdgcn_rcpf(1.f + fexp2(-LOG2E * v[e]));
                } else {
#pragma unroll
                    for (int e = 0; e < 16; ++e) v[e] = __builtin_amdgcn_rcpf(1.f + fexp2(-LOG2E * v[e]));
                }
                u32x4 w0, w1;
                w0.x = cvtpk(v[0], v[1]); w0.y = cvtpk(v[2], v[3]); w0.z = cvtpk(v[4], v[5]); w0.w = cvtpk(v[6], v[7]);
                w1.x = cvtpk(v[8], v[9]); w1.y = cvtpk(v[10], v[11]); w1.z = cvtpk(v[12], v[13]); w1.w = cvtpk(v[14], v[15]);
                const bool lo8 = fr < 8;
                const u32x4 snd = lo8 ? w1 : w0; u32x4 rcv;
                rcv.x = (unsigned)__builtin_amdgcn_update_dpp(0, (int)snd.x, 0x128, 0xF, 0xF, true); rcv.y = (unsigned)__builtin_amdgcn_update_dpp(0, (int)snd.y, 0x128, 0xF, 0xF, true);
                rcv.z = (unsigned)__builtin_amdgcn_update_dpp(0, (int)snd.z, 0x128, 0xF, 0xF, true); rcv.w = (unsigned)__builtin_amdgcn_update_dpp(0, (int)snd.w, 0x128, 0xF, 0xF, true);
                const u32x4 dA = lo8 ? w0 : rcv, dB = lo8 ? rcv : w1;
                bf16* pA = dst + (size_t)(row - (fr & 8)) * pitch + col + 32 * (fr >> 3) + 8 * fq;
                *(u32x4*)pA = dA; *(u32x4*)(pA + (size_t)8 * pitch) = dB;
            }
    }
};

struct SchedP3 {
    pg8::TileOrder o; const unsigned char* A; const unsigned char* B; int scw, sca;
    __device__ __forceinline__ bool next(int i, pg8::Unit& u) const { u.kind = 0; u.f8 = 1; return o.tile(i, u.pm, u.pn); }
    __device__ __forceinline__ void ptrs(const pg8::Unit& u, const char*& a, const char*& b) const { a = (const char*)(A + (size_t)u.pm * 256 * 1024); b = (const char*)(B + (size_t)u.pn * 256 * 1024); }
};
struct EpiP3 {
    const bf16* Gt; unsigned char* MG8;
    __device__ __forceinline__ void mid(f32x4 (&acc)[2][2][4][2], const pg8::Unit& u, int wr, int wc, int fr_, int fq_) const {
        int fr = fr_, fq = fq_; asm volatile("" : "+v"(fr), "+v"(fq));
#pragma unroll
        for (int ai = 0; ai < 2; ++ai)
#pragma unroll
            for (int m = 0; m < 4; ++m) {
                const int row = u.pm * 256 + ai * 128 + wr * 64 + m * 16 + fr;
#pragma unroll
                for (int bj = 0; bj < 2; ++bj) {
                    const int c0 = u.pn * 256 + bj * 128 + wc * 32 + 8 * fq;
                    const u32x4 ga = *(const u32x4*)(Gt + (size_t)row * GP + 1024 + c0), gb = *(const u32x4*)(Gt + (size_t)row * GP + 2048 + c0);
                    f32x4& a0 = acc[ai][bj][m][0]; f32x4& a1 = acc[ai][bj][m][1];
                    a0.x *= bflo(ga.x) * __builtin_amdgcn_rcpf(bflo(gb.x)); a0.y *= bfhi(ga.x) * __builtin_amdgcn_rcpf(bfhi(gb.x)); a0.z *= bflo(ga.y) * __builtin_amdgcn_rcpf(bflo(gb.y)); a0.w *= bfhi(ga.y) * __builtin_amdgcn_rcpf(bfhi(gb.y));
                    a1.x *= bflo(ga.z) * __builtin_amdgcn_rcpf(bflo(gb.z)); a1.y *= bfhi(ga.z) * __builtin_amdgcn_rcpf(bfhi(gb.z)); a1.z *= bflo(ga.w) * __builtin_amdgcn_rcpf(bflo(gb.w)); a1.w *= bfhi(ga.w) * __builtin_amdgcn_rcpf(bfhi(gb.w));
                }
                if (m & 1) asm volatile("" ::: "memory");
            }
    }
    __device__ __forceinline__ void operator()(const f32x4 (&acc)[2][2][4][2], const pg8::Unit& u, int wr, int wc, int fr, int fq) const {
#pragma unroll
        for (int ai = 0; ai < 2; ++ai)
#pragma unroll
            for (int m = 0; m < 4; ++m) {
                const int row = u.pm * 256 + ai * 128 + wr * 64 + m * 16 + fr;
#pragma unroll
                for (int bj = 0; bj < 2; ++bj) {
                    const int c0 = u.pn * 256 + bj * 128 + wc * 32 + 8 * fq;
                    const u32x4 g = *(const u32x4*)(Gt + (size_t)row * GP + 2048 + c0);
                    const f32x4 a0 = acc[ai][bj][m][0], a1 = acc[ai][bj][m][1];
                    u32x2 w8; w8.x = pk4_fp8(a0.x * bflo(g.x) * 64.f, a0.y * bfhi(g.x) * 64.f, a0.z * bflo(g.y) * 64.f, a0.w * bfhi(g.y) * 64.f);
                    w8.y = pk4_fp8(a1.x * bflo(g.z) * 64.f, a1.y * bfhi(g.z) * 64.f, a1.z * bflo(g.w) * 64.f, a1.w * bfhi(g.w) * 64.f);
                    *(u32x2*)(MG8 + (size_t)row * 1024 + c0) = w8;
                }
            }
    }
};
struct SchedP4 {
    pg8::TileOrder o; const unsigned char* A; const unsigned char* B; int scw, sca;
    __device__ __forceinline__ bool next(int i, pg8::Unit& u) const { u.kind = 0; u.f8 = 1; return o.tile(i, u.pm, u.pn); }
    __device__ __forceinline__ void ptrs(const pg8::Unit& u, const char*& a, const char*& b) const { a = (const char*)(A + (size_t)u.pm * 256 * 1024); b = (const char*)(B + (size_t)u.pn * 256 * 1024); }
};
struct EpiP4 {
    const float* xp; const float* xs; float* out;
    __device__ __forceinline__ void operator()(const f32x4 (&acc)[2][2][4][2], const pg8::Unit& u, int wr, int wc, int fr, int fq) const {
#pragma unroll
        for (int ai = 0; ai < 2; ++ai)
#pragma unroll
            for (int m = 0; m < 4; ++m) {
                const int row = u.pm * 256 + ai * 128 + wr * 64 + m * 16 + fr;
                const float* xrow = (row < NP) ? xp + (size_t)row * DM : xs + (size_t)(row - NP) * DM;
                float* orow = out + (size_t)row * DM;
#pragma unroll
                for (int bj = 0; bj < 2; ++bj)
#pragma unroll
                    for (int n = 0; n < 2; ++n) { const int c = u.pn * 256 + bj * 128 + wc * 32 + 16 * n + 4 * fq;
                        *(f32x4*)(orow + c) = *(const f32x4*)(xrow + c) + acc[ai][bj][m][n]; }
            }
    }
};

__device__ __forceinline__ int t5_bucket(int dist) {
    if (dist < 16) return dist;
    const float df = (float)dist;
    int large = 16 + (int)(__log2f(df * (1.f / 16.f)) * (16.f / 7.f));
    return large < 31 ? large : 31;
}
struct AttnCtx { LAS float* tab; LAS unsigned char* vt; LAS float* lx; int lane, r32, hi; float mref2; };
__device__ __forceinline__ int crow(int r, int hi) { return (r & 3) + 8 * (r >> 2) + 4 * hi; }
__device__ __forceinline__ s16x4 vtr(const LAS unsigned char* p) { return __builtin_bit_cast(s16x4, __builtin_amdgcn_ds_read_tr16_b64_v4i16((LAS s16x4*)p)); }

__device__ __forceinline__ void attn_prompt_pair(const bool IS_A, const AttnCtx& c, const bf16* qp, int qstride, const bf16* kp, const bf16* vp, int kstride, int kt0, const LAS float* tb, float sinkterm,
                                                 bf16* op, int ostride, const bf16* gp, int gstride, LAS unsigned char* accb, LAS float* Lb, int arow0, int dstr, int first, int nsub) {
    int lane_ = c.lane; asm volatile("" : "+v"(lane_));
    const int lane = lane_, r32 = lane & 31, hi = lane >> 5;
    const int vkey = lane >> 3, vch = lane & 7;
    LAS unsigned char* kt_lds = c.vt + 4096;
    LAS unsigned char* krw = kt_lds + vkey * 128 + ((vch ^ (vkey & 7)) << 4);
    bf16x8 qf[2][4];
#pragma unroll
    for (int sb = 0; sb < 2; ++sb) {   u32x4 qraw[4];
        const int sbl = (sb < nsub) ? sb : 0;
#pragma unroll
        for (int i = 0; i < 4; ++i) qraw[i] = *(const u32x4*)(qp + (32 * sbl + 8 * i + vkey) * qstride + 8 * vch);
#pragma unroll
        for (int i = 0; i < 4; ++i) *(LAS u32x4*)(c.vt + 4096 * sb + (8 * i + vkey) * 128 + ((vch ^ (vkey & 7)) << 4)) = qraw[i];
#pragma unroll
        for (int d0 = 0; d0 < 4; ++d0) qf[sb][d0] = *(const LAS bf16x8*)(c.vt + 4096 * sb + r32 * 128 + (((2 * d0 + hi) ^ (r32 & 7)) << 4));
    }
    const int pi = (r32 & 19) | ((r32 & 4) << 1) | ((r32 & 8) >> 1);
    const LAS unsigned char* krd = kt_lds + pi * 128;
    const bf16* kl = kp + vkey * kstride + 8 * vch;
    const bf16* vl = vp + vkey * kstride + 8 * vch;
    LAS unsigned char* vw = c.vt + (vch >> 2) * 2048 + vkey * 64 + (vch & 3) * 16;
    const LAS unsigned char* vr = c.vt + (8 * hi + ((lane & 15) >> 2)) * 64 + ((lane >> 4) & 1) * 32 + (lane & 3) * 8;
    const LAS float* tl = tb + 32 + r32 - 8 * hi;
    f32x16 O[2][2];
#pragma unroll
    for (int r = 0; r < 16; ++r) { O[0][0][r] = 0.f; O[0][1][r] = 0.f; O[1][0][r] = 0.f; O[1][1][r] = 0.f; }
    float lsum[2] = {0.f, 0.f};
    bf16x8 kf[4]; u32x4 vraw[4], kraw[4];
    {   const bf16* kb = kl + (32 * kt0) * kstride; const bf16* vb = vl + (32 * kt0) * kstride;
#pragma unroll
        for (int i = 0; i < 4; ++i) kraw[i] = *(const u32x4*)(kb + (8 * i) * kstride);
#pragma unroll
        for (int i = 0; i < 4; ++i) vraw[i] = *(const u32x4*)(vb + (8 * i) * kstride); }
    const int ktl = 3 + nsub;
    for (int kt = kt0; kt <= ktl; ++kt) {
        const int ktn = (kt < ktl) ? kt + 1 : kt;
#pragma unroll
        for (int i = 0; i < 4; ++i) *(LAS u32x4*)(krw + i * 1024) = kraw[i];
#pragma unroll
        for (int i = 0; i < 4; ++i) *(LAS u32x4*)(vw + i * 512) = vraw[i];
        { const bf16* kb = kl + (32 * ktn) * kstride; const bf16* vb = vl + (32 * ktn) * kstride;
#pragma unroll
            for (int i = 0; i < 4; ++i) kraw[i] = *(const u32x4*)(kb + (8 * i) * kstride);
#pragma unroll
            for (int i = 0; i < 4; ++i) vraw[i] = *(const u32x4*)(vb + (8 * i) * kstride); }
#pragma unroll
        for (int d0 = 0; d0 < 4; ++d0) kf[d0] = *(const LAS bf16x8*)(krd + (((2 * d0 + hi) ^ (pi & 7)) << 4));
        const s16x4 a0 = vtr(vr + 0), a1 = vtr(vr + 256), b0 = vtr(vr + 1024), b1 = vtr(vr + 1280), c0 = vtr(vr + 2048), c1 = vtr(vr + 2048 + 256), d0v = vtr(vr + 2048 + 1024), d1v = vtr(vr + 2048 + 1280);
#define PKV(x, y) (bf16x8){x[0], x[1], x[2], x[3], y[0], y[1], y[2], y[3]}
        const bf16x8 v00 = PKV(a0, a1), v01 = PKV(b0, b1), v10 = PKV(c0, c1), v11 = PKV(d0v, d1v);
#undef PKV
#pragma unroll
        for (int sb = 0; sb < 2; ++sb) {
            if (sb == 0 ? (kt <= 4) : (kt >= 1 && nsub == 2)) {
                f32x16 S; const LAS float* tk = tl + (128 + 32 * sb - 32 * kt);
#pragma unroll
                for (int r = 0; r < 16; ++r) S[r] = tk[-16 * (r >> 3) - (r & 7)];
#pragma unroll
                for (int d0 = 0; d0 < 4; ++d0) S = __builtin_amdgcn_mfma_f32_32x32x16_bf16(kf[d0], qf[sb][d0], S, 0, 0, 0);
                float ps = 0.f;
#pragma unroll
                for (int r = 0; r < 16; ++r) { S[r] = fexp2(S[r]); ps += S[r]; }
                lsum[sb] += ps;
                u32x4 pw0, pw1;
                pw0.x = cvtpk(S[0], S[1]); pw0.y = cvtpk(S[2], S[3]); pw0.z = cvtpk(S[4], S[5]); pw0.w = cvtpk(S[6], S[7]);
                pw1.x = cvtpk(S[8], S[9]); pw1.y = cvtpk(S[10], S[11]); pw1.z = cvtpk(S[12], S[13]); pw1.w = cvtpk(S[14], S[15]);
                O[sb][0] = __builtin_amdgcn_mfma_f32_32x32x16_bf16(__builtin_bit_cast(bf16x8, pw0), v00, O[sb][0], 0, 0, 0);
                O[sb][0] = __builtin_amdgcn_mfma_f32_32x32x16_bf16(__builtin_bit_cast(bf16x8, pw1), v01, O[sb][0], 0, 0, 0);
                O[sb][1] = __builtin_amdgcn_mfma_f32_32x32x16_bf16(__builtin_bit_cast(bf16x8, pw0), v10, O[sb][1], 0, 0, 0);
                O[sb][1] = __builtin_amdgcn_mfma_f32_32x32x16_bf16(__builtin_bit_cast(bf16x8, pw1), v11, O[sb][1], 0, 0, 0);
            }
        }
    }
#pragma unroll
    for (int sb = 0; sb < 2; ++sb) {
        if (sb < nsub) {
        float lt = lsum[sb] + __shfl_xor(lsum[sb], 32);
        if (IS_A) lt += sinkterm;
        if (hi == 0) { c.lx[r32] = lt;
            if (!IS_A) { const int rq = arow0 + dstr * (32 * sb + r32); Lb[rq] = first ? lt : Lb[rq] + lt; } }
        LAS bf16* stg = (LAS bf16*)c.vt;
#pragma unroll
        for (int r = 0; r < 16; ++r) { const int q = crow(r, hi); float li = 1.f; if (IS_A) li = __builtin_amdgcn_rcpf(c.lx[q]);
            stg[q * 64 + r32] = (bf16)(cvtpk(O[sb][0][r] * li, 0.f) & 0xffffu); stg[q * 64 + 32 + r32] = (bf16)(cvtpk(O[sb][1][r] * li, 0.f) & 0xffffu); }
#pragma unroll
        for (int i = 0; i < 4; ++i) { const int row = 32 * sb + 8 * i + (lane >> 3), ch = lane & 7;
            u32x4 w = *(const LAS u32x4*)(c.vt + (8 * i + (lane >> 3)) * 128 + ch * 16);
            if (IS_A) { const u32x4 g = *(const u32x4*)(gp + row * gstride + 8 * ch);
                u32x2 w8; w8.x = pk4_fp8(bflo(w.x) * bflo(g.x) * 64.f, bfhi(w.x) * bfhi(g.x) * 64.f, bflo(w.y) * bflo(g.y) * 64.f, bfhi(w.y) * bfhi(g.y) * 64.f);
                w8.y = pk4_fp8(bflo(w.z) * bflo(g.z) * 64.f, bfhi(w.z) * bfhi(g.z) * 64.f, bflo(w.w) * bflo(g.w) * 64.f, bfhi(w.w) * bfhi(g.w) * 64.f);
                *(u32x2*)((unsigned char*)op + row * ostride + 8 * ch) = w8; }
            else {
                const int ra = arow0 + dstr * row;
                LAS u32x4* ap = (LAS u32x4*)(accb + ra * 128 + ((ch ^ (ra & 7)) << 4));
                if (!first) { const u32x4 a = *ap; w.x = cvtpk(bflo(a.x) + bflo(w.x), bfhi(a.x) + bfhi(w.x)); w.y = cvtpk(bflo(a.y) + bflo(w.y), bfhi(a.y) + bfhi(w.y));
                    w.z = cvtpk(bflo(a.z) + bflo(w.z), bfhi(a.z) + bfhi(w.z)); w.w = cvtpk(bflo(a.w) + bflo(w.w), bfhi(a.w) + bfhi(w.w)); }
                *ap = w; } }
        }
    }
}

template <int CTRL> __device__ __forceinline__ float dppf(float v) { return __builtin_bit_cast(float, __builtin_amdgcn_update_dpp(0, __builtin_bit_cast(int, v), CTRL, 0xF, 0xF, true)); }
__device__ __forceinline__ float red8(float s) { s += dppf<0xB1>(s); s += dppf<0x4E>(s); s += dppf<0x141>(s); return s; }

__device__ __forceinline__ void dec_unit(const AttnCtx& c, const Frame& F, int grp  , int n, int t) {
    const bool IS_A = (grp == 0);
    const int hd = c.lane >> 3, sub = c.lane & 7, row = NP + n * 4 + t;
    const int L = (grp <= 1) ? 128 : (grp == 2 ? 512 : 2048), d = (grp <= 1) ? 1 : (grp == 2 ? 4 : 16);
    const int RS = IS_A ? 256 : 1024, VO = IS_A ? 128 : 512;
    const int coff = IS_A ? ((hd >> 2) * 64 + sub * 8) : (hd * 64 + sub * 8);
    const float* cache = IS_A ? F.ca : (grp == 1 ? F.cb1 : (grp == 2 ? F.cb2 : F.cb3));
    const float* cb = cache + (size_t)n * L * RS + coff;
    const float* nb = F.out + (IS_A ? OUT_SA : (grp == 1 ? OUT_SB1 : (grp == 2 ? OUT_SB2 : OUT_SB3))) + (size_t)(n * 4) * RS + coff;
    float qv[8];
    { const u32x4 qw = *(const u32x4*)(F.Q + (size_t)row * QP + (IS_A ? 0 : 512 + (grp - 1) * 512) + hd * 64 + sub * 8);
      qv[0] = bflo(qw.x); qv[1] = bfhi(qw.x); qv[2] = bflo(qw.y); qv[3] = bfhi(qw.y); qv[4] = bflo(qw.z); qv[5] = bfhi(qw.z); qv[6] = bflo(qw.w); qv[7] = bfhi(qw.w); }
    const LAS float* tb = c.tab + (8 * grp + hd) * 192 + 32;
    float acc[8]; float l = 0.f;
#pragma unroll
    for (int e = 0; e < 8; ++e) acc[e] = 0.f;
    f32x4 ak0[4], ak1[4], av0[4], av1[4], bk0[4], bk1[4], bv0[4], bv1[4];
#define DEC_LOAD(K0, K1, V0, V1, J0) do { _Pragma("unroll") for (int u_ = 0; u_ < 4; ++u_) { const int idx_ = L + t - ((J0) + u_) * d; \
        const float* rp_ = (idx_ >= L) ? nb + (size_t)(idx_ - L) * RS : cb + (size_t)idx_ * RS; \
        K0[u_] = *(const f32x4*)rp_; K1[u_] = *(const f32x4*)(rp_ + 4); V0[u_] = *(const f32x4*)(rp_ + VO); V1[u_] = *(const f32x4*)(rp_ + VO + 4); } } while (0)
#define DEC_COMP(K0, K1, V0, V1, J0) do { _Pragma("unroll") for (int u_ = 0; u_ < 4; ++u_) { \
        float s_ = qv[0] * K0[u_].x + qv[1] * K0[u_].y + qv[2] * K0[u_].z + qv[3] * K0[u_].w + qv[4] * K1[u_].x + qv[5] * K1[u_].y + qv[6] * K1[u_].z + qv[7] * K1[u_].w; \
        s_ = red8(s_); const float p_ = fexp2(s_ + tb[(J0) + u_]); l += p_; \
        acc[0] += p_ * V0[u_].x; acc[1] += p_ * V0[u_].y; acc[2] += p_ * V0[u_].z; acc[3] += p_ * V0[u_].w; acc[4] += p_ * V1[u_].x; acc[5] += p_ * V1[u_].y; acc[6] += p_ * V1[u_].z; acc[7] += p_ * V1[u_].w; } } while (0)
    DEC_LOAD(ak0, ak1, av0, av1, 0);
    for (int j0 = 0; j0 < 128; j0 += 8) {
        DEC_LOAD(bk0, bk1, bv0, bv1, j0 + 4);
        DEC_COMP(ak0, ak1, av0, av1, j0);
        if (j0 + 8 < 128) DEC_LOAD(ak0, ak1, av0, av1, j0 + 8);
        DEC_COMP(bk0, bk1, bv0, bv1, j0 + 4);
    }
#undef DEC_LOAD
#undef DEC_COMP
    if (IS_A) {
        const float li = 1.0f / (l + fexp2(F.snk[hd] * LOG2E - c.mref2));
        const u32x4 g = *(const u32x4*)(F.Gt + (size_t)row * GP + hd * 64 + sub * 8);
        u32x4 w; w.x = cvtpk(acc[0] * li * bflo(g.x), acc[1] * li * bfhi(g.x)); w.y = cvtpk(acc[2] * li * bflo(g.y), acc[3] * li * bfhi(g.y));
        w.z = cvtpk(acc[4] * li * bflo(g.z), acc[5] * li * bfhi(g.z)); w.w = cvtpk(acc[6] * li * bflo(g.w), acc[7] * li * bfhi(g.w));
        *(u32x4*)(F.AB + (size_t)row * DM + hd * 64 + sub * 8) = w;
    } else {
        u32x4 w; w.x = cvtpk(acc[0], acc[1]); w.y = cvtpk(acc[2], acc[3]); w.z = cvtpk(acc[4], acc[5]); w.w = cvtpk(acc[6], acc[7]);
        *(u32x4*)(F.OG + ((size_t)(grp - 1) * MR + row) * OGP + hd * 64 + sub * 8) = w;
        if (sub == 0) F.LG[((size_t)(grp - 1) * MR + row) * 8 + hd] = l;
    }
}

__device__ __forceinline__ void p2_setup(Frame& F) {
    LAS float* tab = (LAS float*)(F.lds + AT_TAB);
    LAS float* red = (LAS float*)(F.lds + AT_RED);
    volatile LAS unsigned* qctr = (volatile LAS unsigned*)(F.lds + AT_RED + 128);
    {
        float bm = fmaxf(F.relb[F.tid], F.relb[F.tid + 512]);
        if (F.tid < 8) bm = fmaxf(bm, F.snk[F.tid]);
        float gm = 0.f;
        if (F.tid < 64) gm = fabsf(F.qga[F.tid] * F.kga[F.tid]);
        else if (F.tid < 256) gm = fabsf(F.qgb[F.tid - 64] * F.kgb[F.tid - 64]);
        bm = wave_max(bm); gm = wave_max(gm);
        if (F.lane == 0) { red[F.wave] = bm; red[8 + F.wave] = gm; }
        if (F.tid == 0) { qctr[0] = 0u; qctr[1] = 0u; }
    }
    __syncthreads();
    float mref2;
    { float bm = red[0], gm = red[8];
#pragma unroll
      for (int w = 1; w < 8; ++w) { bm = fmaxf(bm, red[w]); gm = fmaxf(gm, red[8 + w]); }
      mref2 = (8.f * gm + bm) * LOG2E; }
    for (int idx = F.tid; idx < 32 * 192; idx += NTHR) {
        const int tb = idx / 192, e = idx % 192, j = e - 32, grp = tb >> 3, h = tb & 7;
        const int d = (grp <= 1) ? 1 : (grp == 2 ? 4 : 16), col = (grp == 0) ? h : 8 + (grp - 1) * 8 + h;
        float v = NEGBIG;
        if (j >= 0 && j <= 127) v = F.relb[t5_bucket(j * d) * 32 + col] * LOG2E - mref2;
        tab[idx] = v;
    }
    __syncthreads();
    if (F.tid == 0) red[16] = mref2;
    __syncthreads();
}
#define GRAB_JOB(ctr, job) do { unsigned j_ = 0; if (F.lane == 0) j_ = __hip_atomic_fetch_add((LAS unsigned*)(ctr), 1u, __ATOMIC_RELAXED, __HIP_MEMORY_SCOPE_WORKGROUP); \
        (job) = (unsigned)__builtin_amdgcn_readfirstlane((int)j_); } while (0)
#define P2_CTX() LAS float* tab = (LAS float*)(F.lds + AT_TAB); volatile LAS unsigned* qctr = (volatile LAS unsigned*)(F.lds + AT_RED + 128); const float mref2 = ((LAS float*)(F.lds + AT_RED))[16]; \
    AttnCtx c; c.tab = tab; c.vt = F.lds + AT_VT + F.wave * 8192; c.lx = (LAS float*)(F.lds + AT_LX + F.wave * 128); c.lane = F.lane; c.r32 = F.lane & 31; c.hi = F.lane >> 5; c.mref2 = mref2
__device__ __forceinline__ void p2_decode(Frame& F) {
    P2_CTX();
    constexpr int NPAIR = 256;
    const int npair = (F.blk < NPAIR) ? (NPAIR - 1 - F.blk) / F.G + 1 : 0, ndec = 8 * npair;
    unsigned job; GRAB_JOB(qctr, job);
    while ((int)job < REP_DEC * ndec) { const int jd = (int)job % ndec;
        const int pair = F.blk + F.G * (jd >> 3), k = jd & 7, n = pair & 127, half = pair >> 7, t = k & 3;
        dec_unit(c, F, (half == 0) ? ((k < 4) ? 3 : 0) : ((k < 4) ? 2 : 1), n, t);
        GRAB_JOB(qctr, job); }
}
__device__ __forceinline__ void p2_items(Frame& F) {
    P2_CTX(); (void)qctr;
    LAS unsigned char* accb = F.lds + AT_ACC; LAS float* Lb = (LAS float*)(F.lds + AT_LSPAN);
    for (int rep = 0; rep < REP_ITEM; ++rep)
    for (int sidx = F.blk; sidx < 256; sidx += F.G) {
        const int x = sidx & 7, k = sidx >> 3, w = F.wave, h = x;
        const int bB = k >> 3, sp = k & 7, T0 = sp * 512;
#pragma unroll 1
        for (int st = 0; st < 4; ++st) {
            const bool isA = (st == 0);
            const int g = st - 1, d = (st <= 1) ? 1 : (st == 2 ? 4 : 16), nsub = (st == 3) ? 1 : 2, nitem = (st == 3) ? 2 : 1;
            const LAS float* tb = tab + (st * 8 + h) * 192;
#pragma unroll 1
            for (int it = 0; it < nitem; ++it) {
                int b, cls, m0, arow0;
                if (isA) { b = k & 3; cls = 0; m0 = 64 * ((k >> 2) + 8 * w); arow0 = 0; }
                else { b = bB; int mrel; if (st == 1) { cls = 0; mrel = 64 * w; } else if (st == 2) { cls = w >> 1; mrel = 64 * (w & 1); } else { cls = w + 8 * it; mrel = 0; }
                       m0 = T0 / d + mrel; arow0 = cls + d * mrel; }
                const long tok0 = (long)b * SEQ + cls + (long)d * m0;
                const int kt0 = (m0 >= 128) ? 0 : 4 - (m0 >> 5);
                const bf16* qp = isA ? F.Q + tok0 * QP + h * 64 : F.Q + tok0 * QP + 512 + g * 512 + h * 64;
                const bf16* kp = isA ? F.KA + (tok0 - 128L) * KAP + (h >> 2) * 64 : F.KB + (tok0 - 128L * d) * KBP + g * 512 + h * 64;
                const bf16* vp = isA ? F.VA + (tok0 - 128L) * KAP + (h >> 2) * 64 : F.VB + (tok0 - 128L * d) * KBP + g * 512 + h * 64;
                attn_prompt_pair(isA, c, qp, d * QP, kp, vp, isA ? KAP : d * KBP, kt0, tb, isA ? fexp2(F.snk[h] * LOG2E - mref2) : 0.f,
                                 (bf16*)(F.AB8 + tok0 * 1024 + h * 64), 1024, F.Gt + tok0 * GP + h * 64, GP, accb, Lb, arow0, d, st == 1, nsub);
            }
            if (!isA) __syncthreads();
        }
        const int b = bB;
        {
            const int t = F.tid; const float li = __builtin_amdgcn_rcpf(Lb[t]);
            bf16* orow = F.OG + ((size_t)b * SEQ + T0 + t) * OGP + h * 64;
#pragma unroll
            for (int j = 0; j < 8; ++j) { const u32x4 a = *(const LAS u32x4*)(accb + t * 128 + ((j ^ (t & 7)) << 4));
                u32x4 o; o.x = cvtpk(bflo(a.x) * li, bfhi(a.x) * li); o.y = cvtpk(bflo(a.y) * li, bfhi(a.y) * li); o.z = cvtpk(bflo(a.z) * li, bfhi(a.z) * li); o.w = cvtpk(bflo(a.w) * li, bfhi(a.w) * li);
                *(u32x4*)(orow + 8 * j) = o; }
        }
        __syncthreads();
    }
}
#undef P2_CTX
#undef GRAB_JOB
__device__ __forceinline__ void p2b_combine(Frame& F) {
    const int gw = F.blk * NWAVES + F.wave, NGW = F.G * NWAVES, hd = F.lane >> 3;
    for (int r0 = gw; r0 < MR; r0 += 3 * NGW) {
        u32x4 w[3][3], g[3]; float lg[3][3];
#pragma unroll
        for (int u = 0; u < 3; ++u) { const int row = r0 + u * NGW; if (row < MR) {
#pragma unroll
            for (int q = 0; q < 3; ++q) { const bool on = (row >= NP) || (q == 0);
                lg[u][q] = on ? ((row >= NP) ? F.LG[((size_t)q * MR + row) * 8 + hd] : 1.f) : 0.f;
                w[u][q] = on ? *(const u32x4*)(F.OG + ((size_t)q * MR + row) * OGP + F.lane * 8) : (u32x4){0u, 0u, 0u, 0u}; }
            g[u] = *(const u32x4*)(F.Gt + (size_t)row * GP + 512 + F.lane * 8); } }
#pragma unroll
        for (int u = 0; u < 3; ++u) { const int row = r0 + u * NGW; if (row < MR) {
            float acc[8];
#pragma unroll
            for (int e = 0; e < 8; ++e) acc[e] = 0.f;
#pragma unroll
            for (int q = 0; q < 3; ++q) { acc[0] += bflo(w[u][q].x); acc[1] += bfhi(w[u][q].x); acc[2] += bflo(w[u][q].y); acc[3] += bfhi(w[u][q].y); acc[4] += bflo(w[u][q].z); acc[5] += bfhi(w[u][q].z); acc[6] += bflo(w[u][q].w); acc[7] += bfhi(w[u][q].w); }
            const float li = __builtin_amdgcn_rcpf(lg[u][0] + lg[u][1] + lg[u][2]);
            u32x4 o; o.x = cvtpk(acc[0] * li * bflo(g[u].x), acc[1] * li * bfhi(g[u].x)); o.y = cvtpk(acc[2] * li * bflo(g[u].y), acc[3] * li * bfhi(g[u].y));
            o.z = cvtpk(acc[4] * li * bflo(g[u].z), acc[5] * li * bfhi(g[u].z)); o.w = cvtpk(acc[6] * li * bflo(g[u].w), acc[7] * li * bfhi(g[u].w));
            if (row < NP) { u32x2 o8; o8.x = pk4_fp8(acc[0] * li * bflo(g[u].x) * 64.f, acc[1] * li * bfhi(g[u].x) * 64.f, acc[2] * li * bflo(g[u].y) * 64.f, acc[3] * li * bfhi(g[u].y) * 64.f);
                o8.y = pk4_fp8(acc[4] * li * bflo(g[u].z) * 64.f, acc[5] * li * bfhi(g[u].z) * 64.f, acc[6] * li * bflo(g[u].w) * 64.f, acc[7] * li * bfhi(g[u].w) * 64.f);
                *(u32x2*)(F.AB8 + (size_t)row * 1024 + 512 + F.lane * 8) = o8; }
            else *(u32x4*)(F.AB + (size_t)row * DM + 512 + F.lane * 8) = o; } }
    }
}

template <int KW>
__device__ __forceinline__ void small_mma(f32x16 (&acc)[2], const bf16* A, int lda, const bf16* Bt, int ldb, int lane) {
    const int r32 = lane & 31, hi = lane >> 5;
    const bf16* ap = A + (size_t)r32 * lda + 8 * hi; const bf16* bp0 = Bt + (size_t)r32 * ldb + 8 * hi; const bf16* bp1 = bp0 + (size_t)32 * ldb;
    bf16x8 af[KW / 16], b0[KW / 16], b1[KW / 16];
#pragma unroll
    for (int s = 0; s < KW / 16; ++s) { af[s] = *(const bf16x8*)(ap + 16 * s); b0[s] = *(const bf16x8*)(bp0 + 16 * s); b1[s] = *(const bf16x8*)(bp1 + 16 * s); }
#pragma unroll
    for (int s = 0; s < KW / 16; ++s) { acc[0] = __builtin_amdgcn_mfma_f32_32x32x16_bf16(af[s], b0[s], acc[0], 0, 0, 0); acc[1] = __builtin_amdgcn_mfma_f32_32x32x16_bf16(af[s], b1[s], acc[1], 0, 0, 0); }
}
__device__ __forceinline__ void p3_small(Frame& F) {
    LAS float* red = (LAS float*)F.lds;
    for (int piece = F.blk; piece < 256; piece += F.G) {
        const int row0 = NP + 32 * (piece >> 4), col0 = 64 * (piece & 15);
        f32x16 ya[2], yb[2];
#pragma unroll
        for (int r = 0; r < 16; ++r) { ya[0][r] = 0.f; ya[1][r] = 0.f; yb[0][r] = 0.f; yb[1][r] = 0.f; }
        small_mma<64>(ya, F.AB + (size_t)row0 * DM + 64 * F.wave, DM, F.WUP + (size_t)col0 * DM + 64 * F.wave, DM, F.lane);
        small_mma<64>(yb, F.AB + (size_t)row0 * DM + 512 + 64 * F.wave, DM, F.WUP + (size_t)col0 * DM + 512 + 64 * F.wave, DM, F.lane);
#pragma unroll
        for (int cb = 0; cb < 2; ++cb)
#pragma unroll
            for (int r = 0; r < 16; ++r) { red[(((F.wave * 2 + 0) * 2 + cb) * 16 + r) * 64 + F.lane] = ya[cb][r]; red[(((F.wave * 2 + 1) * 2 + cb) * 16 + r) * 64 + F.lane] = yb[cb][r]; }
        __syncthreads();
#pragma unroll
        for (int i = 0; i < 4; ++i) {
            const int e = F.tid + 512 * i, cbr = e >> 6, ln = e & 63, cb = cbr >> 4, r = cbr & 15;
            float sa = 0.f, sb = 0.f;
#pragma unroll
            for (int w = 0; w < 8; ++w) { sa += red[(((w * 2 + 0) * 2 + cb) * 16 + r) * 64 + ln]; sb += red[(((w * 2 + 1) * 2 + cb) * 16 + r) * 64 + ln]; }
            const int row = row0 + crow(r, ln >> 5), col = col0 + cb * 32 + (ln & 31);
            const float ga = bflo((unsigned)F.Gt[(size_t)row * GP + 1024 + col]), gb = bflo((unsigned)F.Gt[(size_t)row * GP + 2048 + col]);
            F.MG[(size_t)row * DM + col] = (bf16)(cvtpk(ga * sa + gb * sb, 0.f) & 0xffffu);
        }
        __syncthreads();
    }
}
__device__ __forceinline__ void p4_small(Frame& F) {
    LAS float* red = (LAS float*)F.lds;
    for (int piece = F.blk; piece < 256; piece += F.G) {
        const int row0 = NP + 32 * (piece >> 4), col0 = 64 * (piece & 15);
        f32x16 y[2];
#pragma unroll
        for (int r = 0; r < 16; ++r) { y[0][r] = 0.f; y[1][r] = 0.f; }
        small_mma<128>(y, F.MG + (size_t)row0 * DM + 128 * F.wave, DM, F.WOUT + (size_t)col0 * DM + 128 * F.wave, DM, F.lane);
#pragma unroll
        for (int cb = 0; cb < 2; ++cb)
#pragma unroll
            for (int r = 0; r < 16; ++r) red[((F.wave * 2 + cb) * 16 + r) * 64 + F.lane] = y[cb][r];
        __syncthreads();
#pragma unroll
        for (int i = 0; i < 4; ++i) {
            const int e = F.tid + 512 * i, cbr = e >> 6, ln = e & 63, cb = cbr >> 4, r = cbr & 15;
            float sa = 0.f;
#pragma unroll
            for (int w = 0; w < 8; ++w) sa += red[((w * 2 + cb) * 16 + r) * 64 + ln];
            const int row = row0 + crow(r, ln >> 5), col = col0 + cb * 32 + (ln & 31);
            F.out[(size_t)row * DM + col] = F.xs[(size_t)(row - NP) * DM + col] + sa;
        }
        __syncthreads();
    }
}

constexpr int N_PHASES = 6;
__global__ void __launch_bounds__(NTHR, 2) fwd_kernel(Args args) {
    extern __shared__ __attribute__((aligned(16))) unsigned char lds_raw[];
    Frame F;
    F.lds = (LAS unsigned char*)lds_raw;
    F.tid = threadIdx.x; F.lane = F.tid & 63; F.wave = __builtin_amdgcn_readfirstlane(F.tid >> 6); F.G = gridDim.x; F.blk = blockIdx.x;
    unsigned char* ws = args.ws;
    F.xp = args.in[0]; F.xs = args.in[1]; F.ca = args.in[2]; F.cb1 = args.in[3]; F.cb2 = args.in[4]; F.cb3 = args.in[5]; F.relb = args.in[6]; F.ng = args.in[7]; F.win = args.in[8];
    F.qga = args.in[9]; F.kga = args.in[10]; F.snk = args.in[11]; F.qgb = args.in[12]; F.kgb = args.in[13]; F.wua = args.in[14]; F.wub = args.in[15]; F.wout = args.in[16]; F.out = args.out;
    F.WIN = (bf16*)(ws + WS_WIN); F.WUP = (bf16*)(ws + WS_WUP); F.WOUT = (bf16*)(ws + WS_WOUT); F.HB = (bf16*)(ws + WS_HB); F.HB8 = ws + WS_HB8; F.WIN8 = ws + WS_WIN8; F.AB8 = ws + WS_AB8; F.MG8 = ws + WS_MG8; F.WUP8 = ws + WS_WUP8; F.WOUT8 = ws + WS_WOUT8; F.Q = (bf16*)(ws + WS_Q); F.KA = (bf16*)(ws + WS_KA); F.VA = (bf16*)(ws + WS_VA);
    F.KB = (bf16*)(ws + WS_KB); F.VB = (bf16*)(ws + WS_VB); F.Gt = (bf16*)(ws + WS_G); F.OG = (bf16*)(ws + WS_OG); F.LG = (float*)(ws + WS_LG); F.AB = (bf16*)(ws + WS_AB); F.T = (bf16*)(ws + WS_T); F.MG = (bf16*)(ws + WS_MG);
    for (int u = F.tid; u < (LDS_BYTES - LDSCTL_OFF) / 4; u += NTHR) ((LAS unsigned*)(F.lds + LDSCTL_OFF))[u] = 0u;
    __syncthreads();
    volatile LAS unsigned* MISC = (volatile LAS unsigned*)(F.lds + MISC_OFF);
    const int lo = args.ph_lo, hi = args.ph_hi;
    XcdBarrier bar; bar.bar = (unsigned*)(ws + WS_CTL) + CW_BAR; bar.x = 0; bar.st = nullptr;
    if (hi - lo > 1) bar = xcd_barrier_post((unsigned*)(ws + WS_CTL) + CW_BAR, MISC + 8);
#define IN(k) (lo <= (k) && (k) < hi)
#define BOTH(k) (IN(k) && IN((k) + 1))
    if (IN(0)) { for (int rep = 0; rep < REP_P0; ++rep) { p0_prologue(F); if (BOTH(0)) xcd_barrier(bar); } }
    if (IN(1)) {
        EpiP1 E{F.Q, F.KA, F.VA, F.KB, F.VB, F.Gt, F.out, F.qga, F.kga, F.qgb, F.kgb};
        { SchedP1 S; S.init(F.G, F.blk, 0); S.A = (const char*)F.HB; S.B = (const char*)F.WIN; pg8::gemm_phase<EpiP1, SchedP1, true, true, false>(F.lds, DM, S, E); }
        { EpiP1F8 E8{F.Q, F.Gt, F.qga, F.qgb}; SchedP1 S; S.init(F.G, F.blk, 1); S.A = (const char*)F.HB8; S.B = (const char*)F.WIN8; pg8::gemm_phase<EpiP1F8, SchedP1, true, true, true>(F.lds, DM, S, E8); }
        if (BOTH(1)) xcd_barrier(bar);
    }
    if (IN(2)) {
        const int par = (F.blk >> 3) & 1;
        EpiP1F8 E8{F.Q, F.Gt, F.qga, F.qgb}; SchedP1 S; S.init(F.G, F.blk, 2); S.A = (const char*)F.HB8; S.B = (const char*)F.WIN8;
        p2_setup(F);
        p2_items(F);
        __syncthreads();
        if (par != 0) pg8::gemm_phase<EpiP1F8, SchedP1, true, true, true>(F.lds, DM, S, E8);
        p2_decode(F);
        __syncthreads();
        if (par == 0) pg8::gemm_phase<EpiP1F8, SchedP1, true, true, true>(F.lds, DM, S, E8);
        if (BOTH(2)) xcd_barrier(bar);
    }
    if (IN(3)) { for (int rep = 0; rep < REP_P2B; ++rep) { p2b_combine(F); if (BOTH(3)) xcd_barrier(bar); } }
    if (IN(4)) {
        for (int rep = 0; rep < REP_P3; ++rep) {
        if (rep == 0) p3_small(F);
        SchedP3 S; S.o.init(NP, DM, F.G, F.blk); S.A = F.AB8; S.B = F.WUP8; S.scw = 0x7A7A7A7A; S.sca = 0x79797979;
        EpiP3 E{F.Gt, F.MG8};
        pg8::gemm_phase<EpiP3, SchedP3, true, true, true, true>(F.lds, DM, S, E);
        if (BOTH(4)) xcd_barrier(bar);
        }
    }
    if (IN(5)) {
        for (int rep = 0; rep < REP_P4; ++rep) {
        SchedP4 S; S.o.init(NP, DM, F.G, F.blk); S.A = F.MG8; S.B = F.WOUT8; S.scw = 0x7A7A7A7A; S.sca = 0x79797979;
        EpiP4 E{F.xp, F.xs, F.out};
        pg8::gemm_phase<EpiP4, SchedP4, true, false, true>(F.lds, DM, S, E);
        if (rep == 0) { __syncthreads(); p4_small(F); }
        if (rep + 1 < REP_P4) xcd_barrier(bar);
        }
    }
#undef IN
#undef BOTH
}

extern "C" void kernel_launch(void* const* d_in, const int* in_sizes, int n_in, void* d_out, int out_size, void* d_ws, size_t ws_size, hipStream_t stream) {
    static int grid = 0;
    if (grid == 0) {
        if (n_in != 17 || out_size != (int)OUT_END || ws_size < WS_END) { fprintf(stderr, "kernel_launch: unexpected shapes (n_in %d out %d ws %zu)\n", n_in, out_size, ws_size); grid = -1; return; }
        int dev = 0, cus = 0, per_cu = 0;
        if (hipGetDevice(&dev) != hipSuccess || hipDeviceGetAttribute(&cus, hipDeviceAttributeMultiprocessorCount, dev) != hipSuccess) { grid = -1; return; }
        if (hipFuncSetAttribute((const void*)fwd_kernel, hipFuncAttributeMaxDynamicSharedMemorySize, LDS_BYTES) != hipSuccess) { fprintf(stderr, "kernel_launch: hipFuncSetAttribute failed\n"); grid = -1; return; }
        if (hipOccupancyMaxActiveBlocksPerMultiprocessor(&per_cu, (const void*)fwd_kernel, NTHR, LDS_BYTES) != hipSuccess || per_cu < 1) { fprintf(stderr, "kernel_launch: occupancy query says %d\n", per_cu); }
        (void)hipGetLastError();
        grid = cus;
    }
    if (grid < 0) return;
    (void)hipMemsetAsync((char*)d_ws + WS_CTL, 0, CTL_ZERO_BYTES, stream);
    Args a{};
    for (int i = 0; i < 17; ++i) a.in[i] = (const float*)d_in[i];
    a.out = (float*)d_out; a.ws = (unsigned char*)d_ws;
#if MK_N_LAUNCHES == 1
#if PROBE_LO >= 0
    a.ph_lo = PROBE_LO; a.ph_hi = PROBE_HI;
    hipLaunchKernelGGL(fwd_kernel, dim3(grid), dim3(NTHR), LDS_BYTES, stream, a);
    (void)hipMemsetAsync((char*)d_ws + WS_CTL, 0, CTL_ZERO_BYTES, stream);
#endif
    a.ph_lo = 0; a.ph_hi = N_PHASES;
    hipLaunchKernelGGL(fwd_kernel, dim3(grid), dim3(NTHR), LDS_BYTES, stream, a);
#else
    for (int p = 0; p < N_PHASES; ++p) { a.ph_lo = p; a.ph_hi = p + 1; hipLaunchKernelGGL(fwd_kernel, dim3(grid), dim3(NTHR), LDS_BYTES, stream, a); }
#endif
}
```

```cpp
#include <hip/hip_runtime.h>
#include <cstdio>
#include <cstdint>

#ifndef MK_N_LAUNCHES
#define MK_N_LAUNCHES 1
#endif

#ifndef REP_P0
#define REP_P0 1
#define REP_P1 1
#define REP_P2 1
#define REP_P2B 1
#define REP_P3 1
#define REP_P4 1
#define REP_DEC 1
#define REP_ITEM 1
#define REP_EPI 1
#define PROBE_GRP -1
#define PROBE_LO -1
#define PROBE_HI -1
#endif
#define GAS __attribute__((address_space(1)))
#define LAS __attribute__((address_space(3)))
typedef unsigned short bf16;
typedef short bf16x8 __attribute__((ext_vector_type(8)));
typedef float f32x4 __attribute__((ext_vector_type(4)));
typedef float f32x2 __attribute__((ext_vector_type(2)));
typedef float f32x16 __attribute__((ext_vector_type(16)));
typedef unsigned u32x4 __attribute__((ext_vector_type(4)));
typedef unsigned u32x2 __attribute__((ext_vector_type(2)));
typedef short s16x4 __attribute__((ext_vector_type(4)));
typedef __bf16 bf16x2_t __attribute__((ext_vector_type(2)));

constexpr int DM = 1024, SEQ = 4096, NBATCH = 4, NP = NBATCH * SEQ, DECB = 128, DECT = 4, NSMP = DECB * DECT, MR = NP + NSMP, CIN = 8448;
constexpr int NWAVES = 8, NTHR = NWAVES * 64;
constexpr float LOG2E = 1.4426950408889634f;
constexpr float QSCALE = 0.125f * LOG2E;
constexpr float NEGBIG = -1.0e30f;
constexpr size_t OUT_YP = 0, OUT_YS = (size_t)NP * DM, OUT_PA = OUT_YS + (size_t)NSMP * DM, OUT_PB1 = OUT_PA + 4 * 128 * 2 * 2 * 64, OUT_PB2 = OUT_PB1 + 4 * 128 * 2 * 8 * 64,
                 OUT_PB3 = OUT_PB2 + 4 * 512 * 2 * 8 * 64, OUT_SA = OUT_PB3 + (size_t)4 * 2048 * 2 * 8 * 64, OUT_SB1 = OUT_SA + 128 * 4 * 2 * 2 * 64, OUT_SB2 = OUT_SB1 + 128 * 4 * 2 * 8 * 64,
                 OUT_SB3 = OUT_SB2 + 128 * 4 * 2 * 8 * 64, OUT_END = OUT_SB3 + 128 * 4 * 2 * 8 * 64;
static_assert(OUT_END == 30146560, "output size");
constexpr size_t MiB = 1u << 20;
constexpr size_t WS_CTL = 0, CTL_ZERO_BYTES = 64 * 1024;
constexpr size_t WS_WIN = 2 * MiB, WS_WUP = 20 * MiB, WS_WOUT = 22 * MiB, WS_HB = 32 * MiB, WS_Q = 72 * MiB, WS_KA = 140 * MiB, WS_VA = 146 * MiB, WS_KB = 152 * MiB, WS_VB = 204 * MiB,
                 WS_G = 256 * MiB, WS_OG = 360 * MiB, WS_LG = 412 * MiB, WS_AB = 416 * MiB, WS_T = 452 * MiB, WS_MG = 488 * MiB, WS_HB8 = 528 * MiB, WS_WIN8 = 548 * MiB, WS_AB8 = 560 * MiB, WS_MG8 = 576 * MiB, WS_WUP8 = 592 * MiB, WS_WOUT8 = 593 * MiB, WS_G8 = 594 * MiB, WS_KVB8 = 642 * MiB, WS_KVA8 = 690 * MiB, WS_Q8 = 694 * MiB, WS_END = 726 * MiB;
constexpr int QP = 2048, KAP = 128, KBP = 1536, GP = 3072, OGP = 512;
constexpr int CW_BAR = 4096;
constexpr int RING_BYTES = 131072, LDSCTL_OFF = RING_BYTES, MISC_OFF = LDSCTL_OFF + 320, LDS_BYTES = 163840;
constexpr int AT_TAB = RING_BYTES + 1024, AT_TAB_BYTES = 32 * 192 * 4, AT_RED = AT_TAB + AT_TAB_BYTES, AT_LX = AT_RED + 256, AT_LSPAN = AT_LX + NWAVES * 128, AT_VT = 0, AT_ACC = NWAVES * 8192;
static_assert(AT_ACC + 512 * 128 <= RING_BYTES && AT_LSPAN + 512 * 4 <= LDS_BYTES && MISC_OFF + 128 <= AT_TAB, "attention LDS");

#define LDS_WAIT() asm volatile("s_waitcnt lgkmcnt(0)" ::: "memory")
#define VM_WAIT() asm volatile("s_waitcnt vmcnt(0)" ::: "memory")
#define RLX_AGENT __ATOMIC_RELAXED, __HIP_MEMORY_SCOPE_AGENT
__device__ __forceinline__ unsigned cvtpk(float lo, float hi) { f32x2 v = {lo, hi}; bf16x2_t b = __builtin_convertvector(v, bf16x2_t); return __builtin_bit_cast(unsigned, b); }
__device__ __forceinline__ float bflo(unsigned w) { return __builtin_bit_cast(float, w << 16); }
__device__ __forceinline__ float bfhi(unsigned w) { return __builtin_bit_cast(float, w & 0xffff0000u); }
constexpr int G8P = 3072; constexpr float G8S = 16.f, G8M = 256.f;
constexpr int KVBP = 3072, KVAP = 256;
constexpr int Q8P = 2048; constexpr float Q8S = 16.f;
typedef __bf16 bf16x2v __attribute__((ext_vector_type(2)));
__device__ __forceinline__ unsigned f8x2_bf16s(unsigned w, bool hiw) { return hiw ? __builtin_bit_cast(unsigned, __builtin_amdgcn_cvt_scalef32_pk_bf16_fp8((int)w, 1.0f / 16.f, true)) : __builtin_bit_cast(unsigned, __builtin_amdgcn_cvt_scalef32_pk_bf16_fp8((int)w, 1.0f / 16.f, false)); }
__device__ __forceinline__ unsigned f8x2_bf16(unsigned w, bool hiw) { return hiw ? __builtin_bit_cast(unsigned, __builtin_amdgcn_cvt_scalef32_pk_bf16_fp8((int)w, 1.0f, true)) : __builtin_bit_cast(unsigned, __builtin_amdgcn_cvt_scalef32_pk_bf16_fp8((int)w, 1.0f, false)); }
typedef float f32x2v __attribute__((ext_vector_type(2)));
__device__ __forceinline__ void f8x8(u32x2 p, float (&o)[8]) {
    const f32x2v a = __builtin_amdgcn_cvt_pk_f32_fp8((int)p.x, false), b = __builtin_amdgcn_cvt_pk_f32_fp8((int)p.x, true), c = __builtin_amdgcn_cvt_pk_f32_fp8((int)p.y, false), d = __builtin_amdgcn_cvt_pk_f32_fp8((int)p.y, true);
    o[0] = a.x; o[1] = a.y; o[2] = b.x; o[3] = b.y; o[4] = c.x; o[5] = c.y; o[6] = d.x; o[7] = d.y;
}
__device__ __forceinline__ bool tile_fp8(int tile) { return tile < 2 || tile == 3 || tile == 4 || (tile >= 5 && tile < 11) || tile >= 23; }
__device__ __forceinline__ unsigned pk4_fp8(float a, float b, float c, float d) { int p = __builtin_amdgcn_cvt_pk_fp8_f32(a, b, 0, false); p = __builtin_amdgcn_cvt_pk_fp8_f32(c, d, p, true); return (unsigned)p; }
__device__ __forceinline__ float fexp2(float x) { return __builtin_amdgcn_exp2f(x); }

namespace pg8 {
constexpr int BM = 256, BK = 64, HALF = 128, HTB = HALF * BK * 2, STAGE_BYTES = 8 * HTB, NXCD = 8, WGM = 8;
__host__ __device__ __forceinline__ int lds_byte(int r, int c) { const int st = (r >> 4) * 2 + (c >> 5), rr = r & 15, cc = c & 31, ob = rr * 64 + cc * 2; return st * 1024 + (ob ^ (((ob >> 9) & 1) << 5)); }
__host__ __device__ __forceinline__ void stage_rc(int b, int& R, int& C) { const int st = b / 1024, sb = b % 1024, swz = sb ^ (((sb >> 9) & 1) << 5); R = (st >> 1) * 16 + swz / 64; C = (st & 1) * 32 + (swz % 64) / 2; }
__host__ __device__ __forceinline__ int perm32(int rho) { const int n = rho >> 4, i = rho & 15; return 8 * (i >> 2) + 4 * n + (i & 3); }
struct Unit { int pm, pn, kind, f8; };
struct TileOrder {
    int nM, nN, nwg, G, c;
    __device__ void init(int M, int N, int G_, int c_) { nM = M / BM; nN = N / BM; nwg = nM * nN; G = G_; c = c_; }
    __device__ bool tile(int i, int& pm, int& pn) const { return tileL((long)i * G + c, pm, pn); }
    __device__ bool tileL(long L, int& pm, int& pn) const {
        if (L < 0 || L >= nwg) return false;
        int wgid = (int)L; { const int q = nwg / NXCD, r = nwg % NXCD, xcd = wgid % NXCD, off = wgid / NXCD; wgid = (xcd < r ? xcd * (q + 1) : r * (q + 1) + (xcd - r) * q) + off; }
        const int nig = WGM * nN, gid = wgid / nig, fm = gid * WGM, gsz = (nM - fm) < WGM ? (nM - fm) : WGM;
        pm = fm + ((wgid % nig) % gsz); pn = (wgid % nig) / gsz; return true;
    }
};

typedef int i32x8 __attribute__((ext_vector_type(8)));
typedef int i32x4v __attribute__((ext_vector_type(4)));
__device__ __forceinline__ i32x8 cat8(bf16x8 x, bf16x8 y) { const i32x4v a = __builtin_bit_cast(i32x4v, x), b = __builtin_bit_cast(i32x4v, y); return __builtin_shufflevector(a, b, 0, 1, 2, 3, 4, 5, 6, 7); }
template <bool M> struct Frag;
template <> struct Frag<true>  { i32x8 v; __device__ __forceinline__ void set(bf16x8 l, bf16x8 h) { v = cat8(l, h); }
    __device__ __forceinline__ bf16x8 lo() const { return __builtin_bit_cast(bf16x8, __builtin_shufflevector(v, v, 0, 1, 2, 3)); } __device__ __forceinline__ bf16x8 hi() const { return __builtin_bit_cast(bf16x8, __builtin_shufflevector(v, v, 4, 5, 6, 7)); }
    __device__ __forceinline__ i32x8 all() const { return v; } };
template <> struct Frag<false> { bf16x8 a, b; __device__ __forceinline__ void set(bf16x8 l, bf16x8 h) { a = l; b = h; }
    __device__ __forceinline__ bf16x8 lo() const { return a; } __device__ __forceinline__ bf16x8 hi() const { return b; } __device__ __forceinline__ i32x8 all() const { return cat8(a, b); } };
template <class Epi, class Sched, bool ALIGN_EPI, bool PERM, bool F8, bool MIDHOOK = false>
__device__ __forceinline__ void gemm_phase(LAS unsigned char* lds, const int K, const Sched& S, const Epi& E) {
    const int tid = threadIdx.x, wid = __builtin_amdgcn_readfirstlane(tid >> 6), lane = tid & 63, wr = wid >> 2, wc = wid & 3, fr = lane & 15, fq = lane >> 4;
    constexpr int PITCH = F8 ? 1024 : 2048;
    unsigned voffA[2], voffB[2];
#pragma unroll
    for (int i = 0; i < 2; ++i) { int R, C; stage_rc(tid * 16 + i * 8192, R, C); const int Rb = PERM ? ((R & ~31) + perm32(R & 31)) : R;
        voffA[i] = (unsigned)(R * PITCH + C * 2); voffB[i] = (unsigned)(Rb * PITCH + C * 2); }
    const size_t kstep = (size_t)(BK * 2);
    const unsigned ldsw = (unsigned)wid * 1024u;
    const int aoff = lds_byte(wr * 64 + fr, fq * 8), boff = lds_byte(wc * 32 + fr, fq * 8);
#define PG8_SA(b, h) (((b) * 2 + (h)) * HTB)
#define PG8_SB(b, h) ((4 + (b) * 2 + (h)) * HTB)
#define PG8_STAGE(bufoff, gbase, v16, v8, f8) do { _Pragma("unroll") for (int _i = 0; _i < 2; ++_i) { const unsigned vo_ = (v16)[_i]; \
        __builtin_amdgcn_global_load_lds((const unsigned*)((const char*)(gbase) + vo_), (LAS unsigned*)(lds + (bufoff) + ldsw + _i * 8192), 16, 0, 0); } } while (0)
#define PG8_STA(bufoff, gbase, f8) PG8_STAGE(bufoff, gbase, voffA, voffA, f8)
#define PG8_STB(bufoff, gbase, f8) PG8_STAGE(bufoff, gbase, voffB, voffB, f8)
#define PG8_HS(f8) ((size_t)HALF * PITCH)
#define PG8_LDA(dst, b, h) do { _Pragma("unroll") for (int m = 0; m < 4; ++m) dst[m].set(*(const LAS bf16x8*)(lds + PG8_SA(b, h) + aoff + m * 2048), *(const LAS bf16x8*)(lds + PG8_SA(b, h) + aoff + m * 2048 + 1024)); } while (0)
#define PG8_LDB(dst, b, h) do { _Pragma("unroll") for (int n = 0; n < 2; ++n) dst[n].set(*(const LAS bf16x8*)(lds + PG8_SB(b, h) + boff + n * 2048), *(const LAS bf16x8*)(lds + PG8_SB(b, h) + boff + n * 2048 + 1024)); } while (0)
#define PG8_LO(x) (x).lo()
#define PG8_HI(x) (x).hi()
#define PG8_MMA16(ai, bj, At, Bt) do { __builtin_amdgcn_s_setprio(1); _Pragma("unroll") for (int m = 0; m < 4; ++m) _Pragma("unroll") for (int n = 0; n < 2; ++n) { \
            acc[ai][bj][m][n] = __builtin_amdgcn_mfma_f32_16x16x32_bf16(PG8_LO(Bt[n]), PG8_LO(At[m]), acc[ai][bj][m][n], 0, 0, 0); \
            acc[ai][bj][m][n] = __builtin_amdgcn_mfma_f32_16x16x32_bf16(PG8_HI(Bt[n]), PG8_HI(At[m]), acc[ai][bj][m][n], 0, 0, 0); } \
        __builtin_amdgcn_s_setprio(0); } while (0)
#define PG8_MMA8(ai, bj, At, Bt) do { __builtin_amdgcn_s_setprio(1); _Pragma("unroll") for (int m = 0; m < 4; ++m) _Pragma("unroll") for (int n = 0; n < 2; ++n) \
            asm volatile("v_mfma_scale_f32_16x16x128_f8f6f4 %0, %1, %2, %0, %3, %4 op_sel_hi:[0,0,0]" : "+v"(acc[ai][bj][m][n]) : "v"(Bt[n].all()), "v"(At[m].all()), "v"(sc_w), "v"(sc_a)); \
        __builtin_amdgcn_s_setprio(0); } while (0)
#define PG8_WAIT_V(n) asm volatile("s_waitcnt vmcnt(" #n ")" ::: "memory")
#define PG8_WAIT_L(n) asm volatile("s_waitcnt lgkmcnt(" #n ")" ::: "memory")
#define PG8_BAR __builtin_amdgcn_s_barrier()
#define PG8_SCHED __builtin_amdgcn_sched_barrier(0)
    Unit cur, nxt; int ui = 0;
    if (!S.next(0, cur)) return;
    f32x4 acc[2][2][4][2];
#pragma unroll
    for (int a = 0; a < 2; ++a)
#pragma unroll
        for (int b = 0; b < 2; ++b)
#pragma unroll
            for (int m = 0; m < 4; ++m)
#pragma unroll
                for (int n = 0; n < 2; ++n) acc[a][b][m][n] = (f32x4){0.f, 0.f, 0.f, 0.f};
    Frag<F8> At[4], B0[2], B1[2];
    const int sc_w = S.scw, sc_a = S.sca;
    const char* cA; const char* cB; S.ptrs(cur, cA, cB);
    constexpr bool cf8 = F8;
    PG8_STB(PG8_SB(0, 0), cB, cf8); PG8_STB(PG8_SB(0, 1), cB + PG8_HS(cf8), cf8); PG8_STA(PG8_SA(0, 0), cA, cf8); PG8_STA(PG8_SA(0, 1), cA + PG8_HS(cf8), cf8);
    if (wr == 1) PG8_BAR;
    PG8_WAIT_V(2); PG8_BAR;
    PG8_STB(PG8_SB(1, 0), cB + kstep, cf8); PG8_STA(PG8_SA(1, 0), cA + kstep, cf8); PG8_STB(PG8_SB(1, 1), cB + PG8_HS(cf8) + kstep, cf8);
    PG8_WAIT_V(6); PG8_BAR;
    for (;;) {
        const bool has_next = S.next(ui + 1, nxt);
        const char* nA = cA; const char* nB = cB; if (has_next) S.ptrs(nxt, nA, nB);
        constexpr bool nf8 = F8;
        const int nt = F8 ? K / 128 : K / BK;
#define PG8_KLOOP(MMA, T0, T1) _Pragma("nounroll") for (int t = (T0); t < (T1); t += 2) { \
            const bool last = (t == nt - 2); \
            const bool f2 = last ? nf8 : cf8;                     \
            const char* a1 = cA + (size_t)(t + 1) * kstep; \
            const char* a2 = last ? nA : cA + (size_t)(t + 2) * kstep; const char* b2 = last ? nB : cB + (size_t)(t + 2) * kstep; \
            const char* a3 = a2 + kstep; const char* b3 = b2 + kstep; \
            PG8_LDB(B0, 0, 0); PG8_LDB(B1, 0, 1); PG8_SCHED; PG8_LDA(At, 0, 0); PG8_STA(PG8_SA(1, 1), a1 + PG8_HS(cf8), cf8); \
            PG8_WAIT_V(8); PG8_WAIT_L(0); PG8_BAR; MMA(0, 0, At, B0); MMA(0, 1, At, B1); PG8_BAR; PG8_SCHED; \
            PG8_LDA(At, 0, 1); PG8_STB(PG8_SB(0, 0), b2, f2); PG8_STB(PG8_SB(0, 1), b2 + PG8_HS(f2), f2); PG8_STA(PG8_SA(0, 0), a2, f2); \
            PG8_WAIT_V(8); PG8_WAIT_L(0); PG8_BAR; MMA(1, 0, At, B0); MMA(1, 1, At, B1); PG8_BAR; PG8_SCHED; \
            PG8_LDB(B0, 1, 0); PG8_LDB(B1, 1, 1); PG8_SCHED; PG8_LDA(At, 1, 0); PG8_STA(PG8_SA(0, 1), a2 + PG8_HS(f2), f2); \
            PG8_WAIT_V(8); PG8_WAIT_L(0); PG8_BAR; MMA(0, 0, At, B0); MMA(0, 1, At, B1); PG8_BAR; PG8_SCHED; \
            PG8_LDA(At, 1, 1); PG8_STB(PG8_SB(1, 0), b3, f2); PG8_STB(PG8_SB(1, 1), b3 + PG8_HS(f2), f2); PG8_STA(PG8_SA(1, 0), a3, f2); \
            PG8_WAIT_V(8); PG8_WAIT_L(0); PG8_BAR; MMA(1, 0, At, B0); MMA(1, 1, At, B1); PG8_BAR; PG8_SCHED; \
        }
        if constexpr (F8 && MIDHOOK) {
            PG8_KLOOP(PG8_MMA8, 0, nt / 2) asm volatile("s_nop 15\n\ts_nop 7" ::: "memory");
            E.mid(acc, cur, wr, wc, fr, fq);
            PG8_KLOOP(PG8_MMA8, nt / 2, nt) asm volatile("s_nop 15\n\ts_nop 7" ::: "memory");
        } else if constexpr (F8) { PG8_KLOOP(PG8_MMA8, 0, nt) asm volatile("s_nop 15\n\ts_nop 7" ::: "memory");   }
        else { PG8_KLOOP(PG8_MMA16, 0, nt) }
#undef PG8_KLOOP
        if constexpr (ALIGN_EPI) { if (wr == 0) PG8_BAR; }
        E(acc, cur, wr, wc, fr, fq);
#if REP_EPI > 1
        asm volatile("" ::: "memory"); E(acc, cur, wr, wc, fr, fq);
#endif
        if (!has_next) break;
#pragma unroll
        for (int a = 0; a < 2; ++a)
#pragma unroll
            for (int b = 0; b < 2; ++b)
#pragma unroll
                for (int m = 0; m < 4; ++m)
#pragma unroll
                    for (int n = 0; n < 2; ++n) acc[a][b][m][n] = (f32x4){0.f, 0.f, 0.f, 0.f};
        cur = nxt; cA = nA; cB = nB; ++ui;
        if constexpr (ALIGN_EPI) { if (wr == 1) PG8_BAR; }
    }
    PG8_WAIT_V(0);
    if constexpr (!ALIGN_EPI) { if (wr == 0) PG8_BAR; }
    PG8_BAR;
#undef PG8_SA
#undef PG8_SB
#undef PG8_STAGE
#undef PG8_STA
#undef PG8_STB
#undef PG8_HS
#undef PG8_LDA
#undef PG8_LDB
#undef PG8_LO
#undef PG8_HI
#undef PG8_MMA16
#undef PG8_MMA8
#undef PG8_WAIT_V
#undef PG8_WAIT_L
#undef PG8_BAR
#undef PG8_SCHED
}
}

#define XB_TMO      128
#define XB_XCNT(j)  (256  + 64 * (j))
#define XB_XSUB(j)  (1280 + 64 * (j))
#define XB_XGEN(j)  (2304 + 64 * (j))
#define XB_TOP      3328
#define XB_TOPGEN   3392
#define XCD_BAR_WORDS 3456
#define XB_SPIN_CAP (1u << 18)
__device__ __forceinline__ unsigned xb_ld(unsigned* p)              { return __hip_atomic_load(p, __ATOMIC_RELAXED, __HIP_MEMORY_SCOPE_AGENT); }
__device__ __forceinline__ unsigned xb_add(unsigned* p, unsigned v) { return __hip_atomic_fetch_add(p, v, __ATOMIC_RELAXED, __HIP_MEMORY_SCOPE_AGENT); }
__device__ __forceinline__ unsigned xb_xcc_id() { return (unsigned)__builtin_amdgcn_s_getreg((3 << 11) | 20) & 0xFu; }
#define XB_SPIN(cond, bar) do { unsigned _sp = 0; while (cond) { __builtin_amdgcn_s_sleep(1); \
    if ((++_sp & 255u) == 0u) { if (xb_ld(&(bar)[XB_TMO])) break; if (_sp > XB_SPIN_CAP) { atomicAdd(&(bar)[XB_TMO], 1u); break; } } } } while (0)
struct XcdBarrier { unsigned* bar; unsigned x; volatile LAS unsigned* st; };
__device__ __forceinline__ XcdBarrier xcd_barrier_post(unsigned* bar, volatile LAS unsigned* st) {
    XcdBarrier b; b.bar = bar; b.x = xb_xcc_id(); b.st = st;
    if (threadIdx.x == 0) (void)xb_add(&bar[XB_XCNT(b.x)], 1u);
    return b;
}
__device__ __forceinline__ void xcd_barrier_complete(unsigned* bar, unsigned x, unsigned& nloc, unsigned& nx) {
    const unsigned G = gridDim.x * gridDim.y * gridDim.z;
    unsigned sum, cnt, mine, sp = 0u;
    for (;;) {
        sum = 0u; cnt = 0u; mine = 0u;
#pragma unroll
        for (unsigned j = 0; j < 16; ++j) { const unsigned c = xb_ld(&bar[XB_XCNT(j)]); sum += c; cnt += (c > 0u) ? 1u : 0u; mine = (j == x) ? c : mine; }
        if (sum == G) break;
        __builtin_amdgcn_s_sleep(1);
        if ((++sp & 255u) == 0u) { if (xb_ld(&bar[XB_TMO])) break; if (sp > XB_SPIN_CAP) { atomicAdd(&bar[XB_TMO], 1u); break; } }
    }
    nloc = mine > 0u ? mine : 1u; nx = cnt > 0u ? cnt : 1u;
}
__device__ __forceinline__ void xcd_barrier_t0(const XcdBarrier& b) {
    {
        unsigned* bar = b.bar;
        __builtin_amdgcn_s_waitcnt(0);
        unsigned nloc = b.st[0], nx = b.st[1];
        if (nloc == 0u) { xcd_barrier_complete(bar, b.x, nloc, nx); b.st[0] = nloc; b.st[1] = nx; }
        const unsigned old = xb_add(&bar[XB_XSUB(b.x)], 1u);
        const unsigned gen = old / nloc;
        if (old + 1u == (gen + 1u) * nloc) {
            __builtin_amdgcn_fence(__ATOMIC_RELEASE, "agent");
            asm volatile("s_waitcnt vmcnt(0)" ::: "memory");
            const unsigned og = xb_add(&bar[XB_TOP], 1u);
            const unsigned tg = og / nx;
            if (og + 1u == (tg + 1u) * nx) xb_add(&bar[XB_TOPGEN], 1u);
            else XB_SPIN(xb_ld(&bar[XB_TOPGEN]) == tg, bar);
            __builtin_amdgcn_fence(__ATOMIC_ACQUIRE, "agent");
            xb_add(&bar[XB_XGEN(b.x)], 1u);
            asm volatile("s_waitcnt vmcnt(0)" ::: "memory");
        } else {
            XB_SPIN(xb_ld(&bar[XB_XGEN(b.x)]) == gen, bar);
            __builtin_amdgcn_fence(__ATOMIC_ACQUIRE, "agent");
            asm volatile("s_waitcnt vmcnt(0)" ::: "memory");
        }
    }
}
__device__ __forceinline__ void xcd_barrier(const XcdBarrier& b) {
    asm volatile("s_waitcnt vmcnt(0)" ::: "memory");
    __syncthreads();
    if (threadIdx.x == 0) xcd_barrier_t0(b);
    __syncthreads();
}

struct Args { const float* in[17]; float* out; unsigned char* ws; int ph_lo, ph_hi; };
struct Frame {
    LAS unsigned char* lds;
    int tid, lane, wave, G, blk;
    const float *xp, *xs, *ca, *cb1, *cb2, *cb3, *relb, *ng, *win, *qga, *kga, *snk, *qgb, *kgb, *wua, *wub, *wout;
    float* out;
    unsigned char *HB8, *WIN8, *AB8, *MG8, *WUP8, *WOUT8, *G8, *KVB8, *KVA8, *Q8; bf16 *WIN, *WUP, *WOUT, *HB, *Q, *KA, *VA, *KB, *VB, *Gt, *OG, *AB, *T, *MG;
    float* LG;
};
__device__ __forceinline__ float wave_sum(float v) {
#pragma unroll
    for (int o = 1; o < 64; o <<= 1) v += __shfl_xor(v, o);
    return v;
}
__device__ __forceinline__ float wave_max(float v) {
#pragma unroll
    for (int o = 1; o < 64; o <<= 1) v = fmaxf(v, __shfl_xor(v, o));
    return v;
}

__device__ __forceinline__ void p0_transpose_item(const float* W, int N, bf16* WT, int ldo, int koff, int rowbase, int k0, int n0, LAS float* scr, int lane, unsigned char* WT8 = nullptr, bool both = false) {
    float tv[32];
#pragma unroll
    for (int i = 0; i < 32; ++i) { const int kk = 2 * i + (lane >> 5); tv[i] = W[(size_t)(k0 + kk) * N + n0 + (lane & 31)]; }
#pragma unroll
    for (int i = 0; i < 32; ++i) { const int kk = 2 * i + (lane >> 5); scr[kk * 33 + (lane & 31)] = tv[i]; }
    LDS_WAIT(); asm volatile("" ::: "memory");
    const int c = lane & 7;
#pragma unroll
    for (int j = 0; j < 4; ++j) { const int n = (lane >> 3) + 8 * j; const LAS float* s = scr + (8 * c) * 33 + n;
        if (WT8) {
            u32x2 o8; o8.x = pk4_fp8(s[0 * 33] * 32.f, s[1 * 33] * 32.f, s[2 * 33] * 32.f, s[3 * 33] * 32.f); o8.y = pk4_fp8(s[4 * 33] * 32.f, s[5 * 33] * 32.f, s[6 * 33] * 32.f, s[7 * 33] * 32.f);
            *(u32x2*)(WT8 + (size_t)(rowbase + n) * 1024 + koff + k0 + 8 * c) = o8;
        }
        if (!WT8 || both) {
        u32x4 o; o.x = cvtpk(s[0 * 33], s[1 * 33]); o.y = cvtpk(s[2 * 33], s[3 * 33]); o.z = cvtpk(s[4 * 33], s[5 * 33]); o.w = cvtpk(s[6 * 33], s[7 * 33]);
        *(u32x4*)(WT + (size_t)(rowbase + n) * ldo + koff + k0 + 8 * c) = o; } }
    LDS_WAIT(); asm volatile("" ::: "memory");
}
constexpr int P0_I_IN = (DM / 64) * (CIN / 32), P0_I_UP = (512 / 64) * (DM / 32), P0_I_OUT = (DM / 64) * (DM / 32), P0_NITEMS = P0_I_IN + 2 * P0_I_UP + P0_I_OUT;
__device__ __forceinline__ void p0_items(Frame& F, const int lo, const int hi, const int w0, const int nw) {
    LAS float* scr = (LAS float*)(F.lds + F.wave * 16384);
    const int gw = F.blk * nw + (F.wave - w0), NGW = F.G * nw;
    constexpr int I_IN = P0_I_IN, I_UP = P0_I_UP;
    for (int it = lo + gw; it < hi; it += NGW) {
        int r = it;
        if (r < I_IN) { const int nblk = CIN / 32, kb = r / nblk, nb = r % nblk, n0 = 32 * nb;
            const int rb = (n0 & ~255) + 128 * ((n0 >> 5) & 1) + 32 * ((n0 >> 6) & 3);
            p0_transpose_item(F.win, CIN, F.WIN, DM, 0, rb, 64 * kb, n0, scr, F.lane, F.WIN8, !tile_fp8(n0 >> 8)); continue; }
        r -= I_IN;
        if (r < I_UP) { const int nblk = DM / 32, kb = r / nblk, nb = r % nblk; p0_transpose_item(F.wua, DM, F.WUP, DM, 0, 32 * nb, 64 * kb, 32 * nb, scr, F.lane, F.WUP8, true); continue; }
        r -= I_UP;
        if (r < I_UP) { const int nblk = DM / 32, kb = r / nblk, nb = r % nblk; p0_transpose_item(F.wub, DM, F.WUP, DM, 512, 32 * nb, 64 * kb, 32 * nb, scr, F.lane, F.WUP8, true); continue; }
        r -= I_UP;
        { const int nblk = DM / 32, kb = r / nblk, nb = r % nblk; p0_transpose_item(F.wout, DM, F.WOUT, DM, 0, 32 * nb, 64 * kb, 32 * nb, scr, F.lane, F.WOUT8, true); }
    }
}
__device__ __forceinline__ void p0_prologue(Frame& F) {
    const int gw = F.blk * NWAVES + F.wave, NGW = F.G * NWAVES;
    p0_items(F, 0, P0_I_IN, 0, NWAVES);
    f32x4 gv[4];
#pragma unroll
    for (int j = 0; j < 4; ++j) gv[j] = *((const f32x4*)F.ng + F.lane + 64 * j);
#define P0_LOADROWS(dst, mbase) do { _Pragma("unroll") for (int u = 0; u < 3; ++u) { const int m = (mbase) + u * NGW; if (m < MR) { \
            const float* xrow = (m < NP) ? F.xp + (size_t)m * DM : F.xs + (size_t)(m - NP) * DM; const f32x4* xr = (const f32x4*)xrow + F.lane; \
            _Pragma("unroll") for (int j = 0; j < 4; ++j) dst[u][j] = xr[64 * j]; } } } while (0)
    f32x4 v[3][4];
    P0_LOADROWS(v, gw);
    for (int m0 = gw; m0 < MR; m0 += 3 * NGW) {
        f32x4 nv[3][4];
#pragma unroll
        for (int u = 0; u < 3; ++u)
#pragma unroll
            for (int j = 0; j < 4; ++j) nv[u][j] = (f32x4){0.f, 0.f, 0.f, 0.f};
        P0_LOADROWS(nv, m0 + 3 * NGW);
#pragma unroll
        for (int u = 0; u < 3; ++u) { const int m = m0 + u * NGW; if (m < MR) {
            float s = 0.f;
#pragma unroll
            for (int j = 0; j < 4; ++j) s += (v[u][j].x * v[u][j].x + v[u][j].y * v[u][j].y) + (v[u][j].z * v[u][j].z + v[u][j].w * v[u][j].w);
            const float rs = 1.0f / sqrtf(wave_sum(s) * (1.f / DM) + 1e-6f);
            if (m >= NP || (m & (SEQ - 1)) >= SEQ / 2) {
            unsigned long long* o8 = (unsigned long long*)(F.HB + (size_t)m * DM) + F.lane;
#pragma unroll
            for (int j = 0; j < 4; ++j) { const f32x4 w = v[u][j] * rs * gv[j]; o8[64 * j] = (unsigned long long)cvtpk(w.x, w.y) | ((unsigned long long)cvtpk(w.z, w.w) << 32); }
            }
            unsigned* p8 = (unsigned*)(F.HB8 + (size_t)m * DM) + F.lane;
#pragma unroll
            for (int j = 0; j < 4; ++j) { const f32x4 w = v[u][j] * rs * gv[j]; p8[64 * j] = pk4_fp8(w.x, w.y, w.z, w.w); } } }
#pragma unroll
        for (int u = 0; u < 3; ++u)
#pragma unroll
            for (int j = 0; j < 4; ++j) v[u][j] = nv[u][j];
    }
#undef P0_LOADROWS
}

struct SchedP1 {
    pg8::TileOrder o; int cls; const char* A; const char* B; int scw, sca;
    __device__ void init(int G, int c, int cls_) { cls = cls_; scw = 0x7A7A7A7A; sca = 0x7F7F7F7F;
        o.init(MR, (cls_ == 0 ? 13 : 10) * 256, G, cls_ == 1 ? G - 1 - c : c); }
    static constexpr int NBF = 206, NKV8 = 652;
    __device__ __forceinline__ bool next(int i, pg8::Unit& u) const {
        u.kind = 0; u.f8 = (cls != 0);
        if (cls == 2) { int pn; const bool ok = o.tile(i, u.pm, pn); u.pn = 23 + pn; return ok; }
        const long L = (long)i * o.G + o.c;
        if (cls == 0) {
            if (L >= NBF) return false;
            if (L < 180) { const int b = (int)L / 45, r = (int)L % 45; int pmr, pn;
                if (r == 0) { pn = 2; pmr = 15; }
                else if (r < 5) { const int k = r - 1; pn = (k < 2) ? 11 + k : 15 + k; pmr = 15; }
                else if (r < 13) { const int q = r - 5, k = q >> 1; pn = (k < 2) ? 13 + k : 17 + k; pmr = 14 + (q & 1); }
                else { const int q = r - 13, k = q >> 3; pn = (k < 2) ? 15 + k : 19 + k; pmr = 8 + (q & 7); }
                u.pm = 16 * b + pmr; u.pn = pn; }
            else { const int s_ = (int)L - 180, k = s_ % 13; u.pm = 64 + s_ / 13; u.pn = (k == 0) ? 2 : 10 + k; }
            return true;
        }
        if (L < NKV8) { const int b = (int)L / 163, r = (int)L % 163; int pmr, k, pn;
            if (r < 104) { pmr = r / 13; k = r % 13; pn = (k == 0) ? 2 : 10 + k; }
            else if (r < 158) { const int q = r - 104; pmr = 8 + q / 9; k = q % 9; pn = (k == 0) ? 2 : (k < 5 ? 10 + k : 12 + k); }
            else { k = r - 158; pmr = 14; pn = (k == 0) ? 2 : (k < 3 ? 10 + k : 14 + k); }
            u.pm = 16 * b + pmr; u.pn = pn; return true; }
        int pn; const bool ok = o.tileL(L - NKV8, u.pm, pn); u.pn = (pn < 2) ? pn : pn + 1; return ok;
    }
    __device__ __forceinline__ void ptrs(const pg8::Unit& u, const char*& a, const char*& b) const {
        const size_t tb = (cls != 0) ? (size_t)256 * 1024 : (size_t)256 * 2048;
        a = A + (size_t)u.pm * tb; b = B + (size_t)u.pn * tb;
    }
};
struct EpiP1 {
    bf16 *Q, *KA, *VA, *KB, *VB, *Gt; float* out; const float *qga, *kga, *qgb, *kgb; unsigned char *KVA8, *KVB8;
    __device__ __forceinline__ void operator()(const f32x4 (&acc)[2][2][4][2], const pg8::Unit& u, int wr, int wc, int fr, int fq) const {
        const int pn = u.pn;
        int mode, pitch, col, ogrp = -1, okv = 0, ohead = 0; bf16* dst; const float* gain = nullptr; float scale = 1.f;
        if (pn < 2) { mode = 0; dst = Q; pitch = QP; col = 256 * pn + 64 * wc; gain = qga; scale = QSCALE; }
        else if (pn == 2) { if (wc < 2) { mode = 0; dst = KA; pitch = KAP; col = 64 * wc; gain = kga; ogrp = 0; okv = 0; ohead = wc; }
                            else { mode = 1; dst = VA; pitch = KAP; col = 64 * (wc - 2); ogrp = 0; okv = 1; ohead = wc - 2; } }
        else if (pn < 5) { mode = 2; dst = Gt; pitch = GP; col = 256 * (pn - 3) + 64 * wc; }
        else if (pn < 11) { mode = 0; dst = Q; pitch = QP; col = 512 + 256 * (pn - 5) + 64 * wc; gain = qgb + 64 * ((pn - 5) >> 1); scale = QSCALE; }
        else if (pn < 17) { const int g = (pn - 11) >> 1; mode = 0; dst = KB; pitch = KBP; col = 256 * (pn - 11) + 64 * wc; gain = kgb + 64 * g; ogrp = 1 + g; okv = 0; ohead = 4 * ((pn - 11) & 1) + wc; }
        else if (pn < 23) { const int g = (pn - 17) >> 1; mode = 1; dst = VB; pitch = KBP; col = 256 * (pn - 17) + 64 * wc; ogrp = 1 + g; okv = 1; ohead = 4 * ((pn - 17) & 1) + wc; }
        else if (pn < 25) { mode = 2; dst = Gt; pitch = GP; col = 512 + 256 * (pn - 23) + 64 * wc; }
        else { mode = 3; dst = Gt; pitch = GP; col = 1024 + 256 * (pn - 25) + 64 * wc; }
        float gvv[16];
        if (mode == 0) {
#pragma unroll
            for (int bj = 0; bj < 2; ++bj) { const f32x4 g0 = *(const f32x4*)(gain + 32 * bj + 8 * fq), g1 = *(const f32x4*)(gain + 32 * bj + 8 * fq + 4);
                gvv[bj * 8 + 0] = g0.x * scale; gvv[bj * 8 + 1] = g0.y * scale; gvv[bj * 8 + 2] = g0.z * scale; gvv[bj * 8 + 3] = g0.w * scale;
                gvv[bj * 8 + 4] = g1.x * scale; gvv[bj * 8 + 5] = g1.y * scale; gvv[bj * 8 + 6] = g1.z * scale; gvv[bj * 8 + 7] = g1.w * scale; }
        }
        const int W = (ogrp <= 1) ? 128 : (ogrp == 2 ? 512 : 2048), H = (ogrp == 0) ? 2 : 8;
        const size_t obp = (ogrp == 0) ? OUT_PA : (ogrp == 1) ? OUT_PB1 : (ogrp == 2) ? OUT_PB2 : OUT_PB3;
        const size_t obs = (ogrp == 0) ? OUT_SA : (ogrp == 1) ? OUT_SB1 : (ogrp == 2) ? OUT_SB2 : OUT_SB3;
#pragma unroll
        for (int ai = 0; ai < 2; ++ai)
#pragma unroll
            for (int m = 0; m < 4; ++m) {
                const int row = u.pm * 256 + ai * 128 + wr * 64 + m * 16 + fr;
                float v[16];
#pragma unroll
                for (int bj = 0; bj < 2; ++bj)
#pragma unroll
                    for (int n = 0; n < 2; ++n) { const f32x4 a = acc[ai][bj][m][n]; v[bj * 8 + n * 4 + 0] = a.x; v[bj * 8 + n * 4 + 1] = a.y; v[bj * 8 + n * 4 + 2] = a.z; v[bj * 8 + n * 4 + 3] = a.w; }
                if (mode == 0) {
                    float ss = 0.f;
#pragma unroll
                    for (int e = 0; e < 16; ++e) ss += v[e] * v[e];
                    ss += __shfl_xor(ss, 16); ss += __shfl_xor(ss, 32);
                    const float rinv = __builtin_amdgcn_rsqf(ss * (1.f / 64.f) + 1e-6f);
#pragma unroll
                    for (int e = 0; e < 16; ++e) v[e] = v[e] * rinv * gvv[e];
                } else if (mode == 2) {
#pragma unroll
                    for (int e = 0; e < 16; ++e) v[e] = v[e] * __builtin_amdgcn_rcpf(1.f + fexp2(-LOG2E * v[e]));
                } else if (mode == 3) {
#pragma unroll
                    for (int e = 0; e < 16; ++e) v[e] = __builtin_amdgcn_rcpf(1.f + fexp2(-LOG2E * v[e]));
                }
                if (ogrp >= 0 && u.pm < NP / 256) {
                    u32x2 p0, p1;
                    p0.x = pk4_fp8(v[0], v[1], v[2], v[3]); p0.y = pk4_fp8(v[4], v[5], v[6], v[7]); p1.x = pk4_fp8(v[8], v[9], v[10], v[11]); p1.y = pk4_fp8(v[12], v[13], v[14], v[15]);
                    unsigned char* pk = (ogrp == 0) ? KVA8 + (size_t)row * KVAP + ohead * 128 + okv * 64 : KVB8 + (size_t)row * KVBP + ((ogrp - 1) * 8 + ohead) * 128 + okv * 64;
                    *(u32x2*)(pk + 8 * fq) = p0; *(u32x2*)(pk + 32 + 8 * fq) = p1;
                } else {
                    u32x4 w0, w1;
                    w0.x = cvtpk(v[0], v[1]); w0.y = cvtpk(v[2], v[3]); w0.z = cvtpk(v[4], v[5]); w0.w = cvtpk(v[6], v[7]);
                    w1.x = cvtpk(v[8], v[9]); w1.y = cvtpk(v[10], v[11]); w1.z = cvtpk(v[12], v[13]); w1.w = cvtpk(v[14], v[15]);
                    const bool lo8 = fr < 8;
                    const u32x4 snd = lo8 ? w1 : w0; u32x4 rcv;
                    rcv.x = (unsigned)__builtin_amdgcn_update_dpp(0, (int)snd.x, 0x128, 0xF, 0xF, true); rcv.y = (unsigned)__builtin_amdgcn_update_dpp(0, (int)snd.y, 0x128, 0xF, 0xF, true);
                    rcv.z = (unsigned)__builtin_amdgcn_update_dpp(0, (int)snd.z, 0x128, 0xF, 0xF, true); rcv.w = (unsigned)__builtin_amdgcn_update_dpp(0, (int)snd.w, 0x128, 0xF, 0xF, true);
                    const u32x4 dA = lo8 ? w0 : rcv, dB = lo8 ? rcv : w1;
                    const int rowA = row - (fr & 8);
                    bf16* pA = dst + (size_t)rowA * pitch + col + 32 * (fr >> 3) + 8 * fq;
                    *(u32x4*)pA = dA; *(u32x4*)(pA + (size_t)8 * pitch) = dB;
                }
                if (ogrp >= 0) {
                    float* o = nullptr;
                    if (row < NP) { const int b = row >> 12, t = row & 4095; if (t >= SEQ - W) o = out + obp + ((size_t)((b * W + t - (SEQ - W)) * 2 + okv) * H + ohead) * 64; }
                    else { const int rs = row - NP; o = out + obs + ((size_t)(rs * 2 + okv) * H + ohead) * 64; }
                    if (o) {
#pragma unroll
                        for (int bj = 0; bj < 2; ++bj) { *(f32x4*)(o + 32 * bj + 8 * fq) = (f32x4){v[bj * 8 + 0], v[bj * 8 + 1], v[bj * 8 + 2], v[bj * 8 + 3]};
                            *(f32x4*)(o + 32 * bj + 8 * fq + 4) = (f32x4){v[bj * 8 + 4], v[bj * 8 + 5], v[bj * 8 + 6], v[bj * 8 + 7]}; }
                    }
                }
            }
    }
};

struct EpiP1F8 {
    bf16 *Q, *Gt; const float *qga, *qgb; unsigned char *G8, *Q8; const float *kga, *kgb; unsigned char *KVA8, *KVB8;
    __device__ __forceinline__ void operator()(const f32x4 (&acc)[2][2][4][2], const pg8::Unit& u, int wr, int wc, int fr, int fq) const {
        const int pn = u.pn;
        int mode, pitch = QP, col = 0; bf16* dst = Q; const float* gain = qga; float scale = QSCALE;
        int kvslot = -1; bool kvA = false;
        if (pn < 2) { mode = 0; dst = Q; pitch = QP; col = 256 * pn + 64 * wc; }
        else if (pn == 2) { kvA = true; if (wc < 2) { mode = 0; gain = kga; scale = 1.f; kvslot = wc * 128; } else { mode = 1; kvslot = (wc - 2) * 128 + 64; } }
        else if (pn < 5) { mode = 2; dst = Gt; pitch = GP; col = 256 * (pn - 3) + 64 * wc; }
        else if (pn < 11) { mode = 0; dst = Q; pitch = QP; col = 512 + 256 * (pn - 5) + 64 * wc; gain = qgb + 64 * ((pn - 5) >> 1); }
        else if (pn < 17) { const int g = (pn - 11) >> 1; mode = 0; gain = kgb + 64 * g; scale = 1.f; kvslot = (g * 8 + 4 * ((pn - 11) & 1) + wc) * 128; }
        else if (pn < 23) { const int g = (pn - 17) >> 1; mode = 1; kvslot = (g * 8 + 4 * ((pn - 17) & 1) + wc) * 128 + 64; }
        else if (pn < 25) { mode = 2; dst = Gt; pitch = GP; col = 512 + 256 * (pn - 23) + 64 * wc; }
        else { mode = 3; dst = Gt; pitch = GP; col = 1024 + 256 * (pn - 25) + 64 * wc; }
        float gvv[16];
        if (mode == 0) {
#pragma unroll
            for (int bj = 0; bj < 2; ++bj) { const f32x4 g0 = *(const f32x4*)(gain + 32 * bj + 8 * fq), g1 = *(const f32x4*)(gain + 32 * bj + 8 * fq + 4);
                gvv[bj * 8 + 0] = g0.x * scale; gvv[bj * 8 + 1] = g0.y * scale; gvv[bj * 8 + 2] = g0.z * scale; gvv[bj * 8 + 3] = g0.w * scale;
                gvv[bj * 8 + 4] = g1.x * scale; gvv[bj * 8 + 5] = g1.y * scale; gvv[bj * 8 + 6] = g1.z * scale; gvv[bj * 8 + 7] = g1.w * scale; }
        }
#pragma unroll
        for (int ai = 0; ai < 2; ++ai)
#pragma unroll
            for (int m = 0; m < 4; ++m) {
                const int row = u.pm * 256 + ai * 128 + wr * 64 + m * 16 + fr;
                float v[16];
#pragma unroll
                for (int bj = 0; bj < 2; ++bj)
#pragma unroll
                    for (int n = 0; n < 2; ++n) { const f32x4 a = acc[ai][bj][m][n]; v[bj * 8 + n * 4 + 0] = a.x; v[bj * 8 + n * 4 + 1] = a.y; v[bj * 8 + n * 4 + 2] = a.z; v[bj * 8 + n * 4 + 3] = a.w; }
                if (mode == 0) {
                    float ss = 0.f;
#pragma unroll
                    for (int e = 0; e < 16; ++e) ss += v[e] * v[e];
                    ss += __shfl_xor(ss, 16); ss += __shfl_xor(ss, 32);
                    const float rinv = __builtin_amdgcn_rsqf(ss * (1.f / 64.f) + 1e-6f);
#pragma unroll
                    for (int e = 0; e < 16; ++e) v[e] = v[e] * rinv * gvv[e];
                } else if (mode == 2) {
#pragma unroll
                    for (int e = 0; e < 16; ++e) v[e] = v[e] * __builtin_amdgcn_rcpf(1.f + fexp2(-LOG2E * v[e]));
                } else if (mode == 3) {
#pragma unroll
                    for (int e = 0; e < 16; ++e) v[e] = __builtin_amdgcn_rcpf(1.f + fexp2(-LOG2E * v[e]));
                }
                if (kvslot >= 0) {
                    u32x2 p0, p1;
                    p0.x = pk4_fp8(v[0], v[1], v[2], v[3]); p0.y = pk4_fp8(v[4], v[5], v[6], v[7]); p1.x = pk4_fp8(v[8], v[9], v[10], v[11]); p1.y = pk4_fp8(v[12], v[13], v[14], v[15]);
                    unsigned char* pk = (kvA ? KVA8 + (size_t)row * KVAP : KVB8 + (size_t)row * KVBP) + kvslot + 8 * fq;
                    *(u32x2*)pk = p0; *(u32x2*)(pk + 32) = p1;
                    continue;
                }
                if (u.pm < NP / 256) {
                    const float sc = (mode == 0) ? Q8S : (mode == 2) ? G8S : G8M;
                    u32x2 p0, p1;
                    p0.x = pk4_fp8(v[0] * sc, v[1] * sc, v[2] * sc, v[3] * sc); p0.y = pk4_fp8(v[4] * sc, v[5] * sc, v[6] * sc, v[7] * sc);
                    p1.x = pk4_fp8(v[8] * sc, v[9] * sc, v[10] * sc, v[11] * sc); p1.y = pk4_fp8(v[12] * sc, v[13] * sc, v[14] * sc, v[15] * sc);
                    unsigned char* pg = ((mode == 0) ? Q8 + (size_t)row * Q8P : G8 + (size_t)row * G8P) + col + 8 * fq;
                    *(u32x2*)pg = p0; *(u32x2*)(pg + 32) = p1;
                    continue;
                }
                u32x4 w0, w1;
                w0.x = cvtpk(v[0], v[1]); w0.y = cvtpk(v[2], v[3]); w0.z = cvtpk(v[4], v[5]); w0.w = cvtpk(v[6], v[7]);
                w1.x = cvtpk(v[8], v[9]); w1.y = cvtpk(v[10], v[11]); w1.z = cvtpk(v[12], v[13]); w1.w = cvtpk(v[14], v[15]);
                const bool lo8 = fr < 8;
                const u32x4 snd = lo8 ? w1 : w0; u32x4 rcv;
                rcv.x = (unsigned)__builtin_amdgcn_update_dpp(0, (int)snd.x, 0x128, 0xF, 0xF, true); rcv.y = (unsigned)__builtin_amdgcn_update_dpp(0, (int)snd.y, 0x128, 0xF, 0xF, true);
                rcv.z = (unsigned)__builtin_amdgcn_update_dpp(0, (int)snd.z, 0x128, 0xF, 0xF, true); rcv.w = (unsigned)__builtin_amdgcn_update_dpp(0, (int)snd.w, 0x128, 0xF, 0xF, true);
                const u32x4 dA = lo8 ? w0 : rcv, dB = lo8 ? rcv : w1;
                bf16* pA = dst + (size_t)(row - (fr & 8)) * pitch + col + 32 * (fr >> 3) + 8 * fq;
                *(u32x4*)pA = dA; *(u32x4*)(pA + (size_t)8 * pitch) = dB;
            }
    }
};

struct SchedP3 {
    pg8::TileOrder o; const unsigned char* A; const unsigned char* B; int scw, sca;
    __device__ __forceinline__ bool next(int i, pg8::Unit& u) const { u.kind = 0; u.f8 = 1; return o.tile(i, u.pm, u.pn); }
    __device__ __forceinline__ void ptrs(const pg8::Unit& u, const char*& a, const char*& b) const { a = (const char*)(A + (size_t)u.pm * 256 * 1024); b = (const char*)(B + (size_t)u.pn * 256 * 1024); }
};
struct EpiP3 {
    const unsigned char* G8; unsigned char* MG8;
    __device__ __forceinline__ void mid(f32x4 (&acc)[2][2][4][2], const pg8::Unit& u, int wr, int wc, int fr_, int fq_) const {
        int fr = fr_, fq = fq_; asm volatile("" : "+v"(fr), "+v"(fq));
#pragma unroll
        for (int ai = 0; ai < 2; ++ai)
#pragma unroll
            for (int m = 0; m < 4; ++m) {
                const int row = u.pm * 256 + ai * 128 + wr * 64 + m * 16 + fr;
#pragma unroll
                for (int bj = 0; bj < 2; ++bj) {
                    const int c0 = u.pn * 256 + bj * 128 + wc * 32 + 8 * fq;
                    float ga[8], gb[8];
                    f8x8(*(const u32x2*)(G8 + (size_t)row * G8P + 1024 + c0), ga); f8x8(*(const u32x2*)(G8 + (size_t)row * G8P + 2048 + c0), gb);
                    f32x4& a0 = acc[ai][bj][m][0]; f32x4& a1 = acc[ai][bj][m][1];
#define P3_RT(e) (ga[e] * __builtin_amdgcn_rcpf(fmaxf(gb[e], 0.001953125f)))
                    a0.x *= P3_RT(0); a0.y *= P3_RT(1); a0.z *= P3_RT(2); a0.w *= P3_RT(3);
                    a1.x *= P3_RT(4); a1.y *= P3_RT(5); a1.z *= P3_RT(6); a1.w *= P3_RT(7);
#undef P3_RT
                }
            }
    }
    __device__ __forceinline__ void operator()(const f32x4 (&acc)[2][2][4][2], const pg8::Unit& u, int wr, int wc, int fr, int fq) const {
        u32x2 gg[2][4][2];
#pragma unroll
        for (int ai = 0; ai < 2; ++ai)
#pragma unroll
            for (int m = 0; m < 4; ++m) {
                const int row = u.pm * 256 + ai * 128 + wr * 64 + m * 16 + fr;
#pragma unroll
                for (int bj = 0; bj < 2; ++bj) gg[ai][m][bj] = *(const u32x2*)(G8 + (size_t)row * G8P + 2048 + u.pn * 256 + bj * 128 + wc * 32 + 8 * fq);
            }
#pragma unroll
        for (int ai = 0; ai < 2; ++ai)
#pragma unroll
            for (int m = 0; m < 4; ++m) {
                const int row = u.pm * 256 + ai * 128 + wr * 64 + m * 16 + fr;
#pragma unroll
                for (int bj = 0; bj < 2; ++bj) {
                    const int c0 = u.pn * 256 + bj * 128 + wc * 32 + 8 * fq;
                    float g[8]; f8x8(gg[ai][m][bj], g);
                    constexpr float GS = 64.f / G8M;
                    const f32x4 a0 = acc[ai][bj][m][0], a1 = acc[ai][bj][m][1];
                    u32x2 w8; w8.x = pk4_fp8(a0.x * g[0] * GS, a0.y * g[1] * GS, a0.z * g[2] * GS, a0.w * g[3] * GS);
                    w8.y = pk4_fp8(a1.x * g[4] * GS, a1.y * g[5] * GS, a1.z * g[6] * GS, a1.w * g[7] * GS);
                    *(u32x2*)(MG8 + (size_t)row * 1024 + c0) = w8;
                }
            }
    }
};
struct SchedP4 {
    pg8::TileOrder o; const unsigned char* A; const unsigned char* B; int scw, sca;
    __device__ __forceinline__ bool next(int i, pg8::Unit& u) const { u.kind = 0; u.f8 = 1; return o.tile(i, u.pm, u.pn); }
    __device__ __forceinline__ void ptrs(const pg8::Unit& u, const char*& a, const char*& b) const { a = (const char*)(A + (size_t)u.pm * 256 * 1024); b = (const char*)(B + (size_t)u.pn * 256 * 1024); }
};
struct EpiP4 {
    const float* xp; const float* xs; float* out;
    __device__ __forceinline__ void operator()(const f32x4 (&acc)[2][2][4][2], const pg8::Unit& u, int wr, int wc, int fr, int fq) const {
#pragma unroll
        for (int ai = 0; ai < 2; ++ai) {
            f32x4 xv[4][2][2];
#pragma unroll
            for (int m = 0; m < 4; ++m) {
                const int row = u.pm * 256 + ai * 128 + wr * 64 + m * 16 + fr;
                const float* xrow = (row < NP) ? xp + (size_t)row * DM : xs + (size_t)(row - NP) * DM;
#pragma unroll
                for (int bj = 0; bj < 2; ++bj)
#pragma unroll
                    for (int n = 0; n < 2; ++n) xv[m][bj][n] = *(const f32x4*)(xrow + u.pn * 256 + bj * 128 + wc * 32 + 16 * n + 4 * fq);
            }
#pragma unroll
            for (int m = 0; m < 4; ++m) {
                const int row = u.pm * 256 + ai * 128 + wr * 64 + m * 16 + fr;
                float* orow = out + (size_t)row * DM;
#pragma unroll
                for (int bj = 0; bj < 2; ++bj)
#pragma unroll
                    for (int n = 0; n < 2; ++n) *(f32x4*)(orow + u.pn * 256 + bj * 128 + wc * 32 + 16 * n + 4 * fq) = xv[m][bj][n] + acc[ai][bj][m][n];
            }
        }
    }
};

__device__ __forceinline__ int t5_bucket(int dist) {
    if (dist < 16) return dist;
    const float df = (float)dist;
    int large = 16 + (int)(__log2f(df * (1.f / 16.f)) * (16.f / 7.f));
    return large < 31 ? large : 31;
}
struct AttnCtx { LAS float* tab; LAS unsigned char* vt; LAS float* lx; int lane, r32, hi; float mref2; };
__device__ __forceinline__ int crow(int r, int hi) { return (r & 3) + 8 * (r >> 2) + 4 * hi; }
__device__ __forceinline__ s16x4 vtr(const LAS unsigned char* p) { return __builtin_bit_cast(s16x4, __builtin_amdgcn_ds_read_tr16_b64_v4i16((LAS s16x4*)p)); }

__device__ __forceinline__ void attn_prompt_pair(const bool IS_A, const AttnCtx& c, const unsigned char* qp, int qstride, const unsigned char* kvp, int kvstride, int kt0, const LAS float* tb, float sinkterm,
                                                 bf16* op, int ostride, const unsigned char* gp, int gstride, LAS unsigned char* accb, LAS float* Lb, int arow0, int dstr, int first, int nsub) {
    int lane_ = c.lane; asm volatile("" : "+v"(lane_));
    const int lane = lane_, r32 = lane & 31, hi = lane >> 5;
    const int vkey = lane >> 3, vch = lane & 7;
    LAS unsigned char* kt_lds = c.vt + 4096;
    bf16x8 qf[2][4];
#pragma unroll
    for (int sb = 0; sb < 2; ++sb) {   u32x2 qraw[4];
        const int sbl = (sb < nsub) ? sb : 0;
#pragma unroll
        for (int i = 0; i < 4; ++i) qraw[i] = *(const u32x2*)(qp + (32 * sbl + 8 * i + vkey) * qstride + 8 * vch);
#pragma unroll
        for (int i = 0; i < 4; ++i) { u32x4 qb; qb.x = f8x2_bf16s(qraw[i].x, false); qb.y = f8x2_bf16s(qraw[i].x, true); qb.z = f8x2_bf16s(qraw[i].y, false); qb.w = f8x2_bf16s(qraw[i].y, true);
            *(LAS u32x4*)(c.vt + 4096 * sb + (8 * i + vkey) * 128 + ((vch ^ (vkey & 7)) << 4)) = qb; }
#pragma unroll
        for (int d0 = 0; d0 < 4; ++d0) qf[sb][d0] = *(const LAS bf16x8*)(c.vt + 4096 * sb + r32 * 128 + (((2 * d0 + hi) ^ (r32 & 7)) << 4));
    }
    const int pi = (r32 & 19) | ((r32 & 4) << 1) | ((r32 & 8) >> 1);
    const LAS unsigned char* krd = kt_lds + pi * 128;
    const unsigned char* kvl = kvp + vkey * kvstride + 16 * vch;
    const int vc = vch & 3, wo0 = (vch < 4) ? 4096 + vkey * 128 + (((2 * vc) ^ vkey) << 4) : (vc >> 1) * 2048 + vkey * 64 + (vc & 1) * 32, wistr = (vch < 4) ? 1024 : 512;
    LAS unsigned char* kvw0 = c.vt + wo0; LAS unsigned char* kvw1 = c.vt + (wo0 ^ 16);
    const LAS unsigned char* vr = c.vt + (8 * hi + ((lane & 15) >> 2)) * 64 + ((lane >> 4) & 1) * 32 + (lane & 3) * 8;
    const LAS float* tl = tb + 32 + r32 - 8 * hi;
    f32x16 O[2][2];
#pragma unroll
    for (int r = 0; r < 16; ++r) { O[0][0][r] = 0.f; O[0][1][r] = 0.f; O[1][0][r] = 0.f; O[1][1][r] = 0.f; }
    float lsum[2] = {0.f, 0.f};
    bf16x8 kf[4]; u32x4 kv[4];
    {   const unsigned char* kvb = kvl + (32 * kt0) * kvstride;
#pragma unroll
        for (int i = 0; i < 4; ++i) kv[i] = *(const u32x4*)(kvb + (8 * i) * kvstride); }
    const int ktl = 3 + nsub;
    for (int kt = kt0; kt <= ktl; ++kt) {
        const int ktn = (kt < ktl) ? kt + 1 : kt;
#pragma unroll
        for (int i = 0; i < 4; ++i) {
            u32x4 lo, hi4;
            lo.x = f8x2_bf16(kv[i].x, false); lo.y = f8x2_bf16(kv[i].x, true); lo.z = f8x2_bf16(kv[i].y, false); lo.w = f8x2_bf16(kv[i].y, true);
            hi4.x = f8x2_bf16(kv[i].z, false); hi4.y = f8x2_bf16(kv[i].z, true); hi4.z = f8x2_bf16(kv[i].w, false); hi4.w = f8x2_bf16(kv[i].w, true);
            *(LAS u32x4*)(kvw0 + i * wistr) = lo; *(LAS u32x4*)(kvw1 + i * wistr) = hi4;
        }
        { const unsigned char* kvb = kvl + (32 * ktn) * kvstride;
#pragma unroll
            for (int i = 0; i < 4; ++i) kv[i] = *(const u32x4*)(kvb + (8 * i) * kvstride); }
#pragma unroll
        for (int d0 = 0; d0 < 4; ++d0) kf[d0] = *(const LAS bf16x8*)(krd + (((2 * d0 + hi) ^ (pi & 7)) << 4));
        const s16x4 a0 = vtr(vr + 0), a1 = vtr(vr + 256), b0 = vtr(vr + 1024), b1 = vtr(vr + 1280), c0 = vtr(vr + 2048), c1 = vtr(vr + 2048 + 256), d0v = vtr(vr + 2048 + 1024), d1v = vtr(vr + 2048 + 1280);
#define PKV(x, y) (bf16x8){x[0], x[1], x[2], x[3], y[0], y[1], y[2], y[3]}
        const bf16x8 v00 = PKV(a0, a1), v01 = PKV(b0, b1), v10 = PKV(c0, c1), v11 = PKV(d0v, d1v);
#undef PKV
#pragma unroll
        for (int sb = 0; sb < 2; ++sb) {
            if (sb == 0 ? (kt <= 4) : (kt >= 1 && nsub == 2)) {
                f32x16 S; const LAS float* tk = tl + (128 + 32 * sb - 32 * kt);
#pragma unroll
                for (int r = 0; r < 16; ++r) S[r] = tk[-16 * (r >> 3) - (r & 7)];
#pragma unroll
                for (int d0 = 0; d0 < 4; ++d0) S = __builtin_amdgcn_mfma_f32_32x32x16_bf16(kf[d0], qf[sb][d0], S, 0, 0, 0);
                float ps = 0.f;
#pragma unroll
                for (int r = 0; r < 16; ++r) { S[r] = fexp2(S[r]); ps += S[r]; }
                lsum[sb] += ps;
                u32x4 pw0, pw1;
                pw0.x = cvtpk(S[0], S[1]); pw0.y = cvtpk(S[2], S[3]); pw0.z = cvtpk(S[4], S[5]); pw0.w = cvtpk(S[6], S[7]);
                pw1.x = cvtpk(S[8], S[9]); pw1.y = cvtpk(S[10], S[11]); pw1.z = cvtpk(S[12], S[13]); pw1.w = cvtpk(S[14], S[15]);
                O[sb][0] = __builtin_amdgcn_mfma_f32_32x32x16_bf16(__builtin_bit_cast(bf16x8, pw0), v00, O[sb][0], 0, 0, 0);
                O[sb][0] = __builtin_amdgcn_mfma_f32_32x32x16_bf16(__builtin_bit_cast(bf16x8, pw1), v01, O[sb][0], 0, 0, 0);
                O[sb][1] = __builtin_amdgcn_mfma_f32_32x32x16_bf16(__builtin_bit_cast(bf16x8, pw0), v10, O[sb][1], 0, 0, 0);
                O[sb][1] = __builtin_amdgcn_mfma_f32_32x32x16_bf16(__builtin_bit_cast(bf16x8, pw1), v11, O[sb][1], 0, 0, 0);
            }
        }
    }
#pragma unroll
    for (int sb = 0; sb < 2; ++sb) {
        if (sb < nsub) {
        float lt = lsum[sb] + __shfl_xor(lsum[sb], 32);
        if (IS_A) lt += sinkterm;
        if (hi == 0) { c.lx[r32] = lt;
            if (!IS_A) { const int rq = arow0 + dstr * (32 * sb + r32); Lb[rq] = first ? lt : Lb[rq] + lt; } }
        LAS bf16* stg = (LAS bf16*)c.vt;
#pragma unroll
        for (int r = 0; r < 16; ++r) { const int q = crow(r, hi); float li = 1.f; if (IS_A) li = __builtin_amdgcn_rcpf(c.lx[q]);
            stg[q * 64 + r32] = (bf16)(cvtpk(O[sb][0][r] * li, 0.f) & 0xffffu); stg[q * 64 + 32 + r32] = (bf16)(cvtpk(O[sb][1][r] * li, 0.f) & 0xffffu); }
#pragma unroll
        for (int i = 0; i < 4; ++i) { const int row = 32 * sb + 8 * i + (lane >> 3), ch = lane & 7;
            u32x4 w = *(const LAS u32x4*)(c.vt + (8 * i + (lane >> 3)) * 128 + ch * 16);
            if (IS_A) { float g[8]; f8x8(*(const u32x2*)(gp + row * gstride + 8 * ch), g);
                constexpr float GS = 64.f / G8S;
                u32x2 w8; w8.x = pk4_fp8(bflo(w.x) * g[0] * GS, bfhi(w.x) * g[1] * GS, bflo(w.y) * g[2] * GS, bfhi(w.y) * g[3] * GS);
                w8.y = pk4_fp8(bflo(w.z) * g[4] * GS, bfhi(w.z) * g[5] * GS, bflo(w.w) * g[6] * GS, bfhi(w.w) * g[7] * GS);
                *(u32x2*)((unsigned char*)op + row * ostride + 8 * ch) = w8; }
            else {
                const int ra = arow0 + dstr * row;
                LAS u32x4* ap = (LAS u32x4*)(accb + ra * 128 + ((ch ^ (ra & 7)) << 4));
                if (!first) { const u32x4 a = *ap; w.x = cvtpk(bflo(a.x) + bflo(w.x), bfhi(a.x) + bfhi(w.x)); w.y = cvtpk(bflo(a.y) + bflo(w.y), bfhi(a.y) + bfhi(w.y));
                    w.z = cvtpk(bflo(a.z) + bflo(w.z), bfhi(a.z) + bfhi(w.z)); w.w = cvtpk(bflo(a.w) + bflo(w.w), bfhi(a.w) + bfhi(w.w)); }
                *ap = w; } }
        }
    }
}

template <int CTRL> __device__ __forceinline__ float dppf(float v) { return __builtin_bit_cast(float, __builtin_amdgcn_update_dpp(0, __builtin_bit_cast(int, v), CTRL, 0xF, 0xF, true)); }
__device__ __forceinline__ float red8(float s) { s += dppf<0xB1>(s); s += dppf<0x4E>(s); s += dppf<0x141>(s); return s; }

__device__ __forceinline__ void dec_unit(const AttnCtx& c, const Frame& F, int grp  , int n, int t) {
    const bool IS_A = (grp == 0);
    const int hd = c.lane >> 3, sub = c.lane & 7, row = NP + n * 4 + t;
    const int L = (grp <= 1) ? 128 : (grp == 2 ? 512 : 2048), d = (grp <= 1) ? 1 : (grp == 2 ? 4 : 16);
    const int RS = IS_A ? 256 : 1024, VO = IS_A ? 128 : 512;
    const int coff = IS_A ? ((hd >> 2) * 64 + sub * 8) : (hd * 64 + sub * 8);
    const float* cache = IS_A ? F.ca : (grp == 1 ? F.cb1 : (grp == 2 ? F.cb2 : F.cb3));
    const float* cb = cache + (size_t)n * L * RS + coff;
    const float* nb = F.out + (IS_A ? OUT_SA : (grp == 1 ? OUT_SB1 : (grp == 2 ? OUT_SB2 : OUT_SB3))) + (size_t)(n * 4) * RS + coff;
    float qv[8];
    { const u32x4 qw = *(const u32x4*)(F.Q + (size_t)row * QP + (IS_A ? 0 : 512 + (grp - 1) * 512) + hd * 64 + sub * 8);
      qv[0] = bflo(qw.x); qv[1] = bfhi(qw.x); qv[2] = bflo(qw.y); qv[3] = bfhi(qw.y); qv[4] = bflo(qw.z); qv[5] = bfhi(qw.z); qv[6] = bflo(qw.w); qv[7] = bfhi(qw.w); }
    const LAS float* tb = c.tab + (8 * grp + hd) * 192 + 32;
    float acc[8]; float l = 0.f;
#pragma unroll
    for (int e = 0; e < 8; ++e) acc[e] = 0.f;
    f32x4 ak0[4], ak1[4], av0[4], av1[4], bk0[4], bk1[4], bv0[4], bv1[4];
#define DEC_LOAD(K0, K1, V0, V1, J0) do { _Pragma("unroll") for (int u_ = 0; u_ < 4; ++u_) { const int idx_ = L + t - ((J0) + u_) * d; \
        const float* rp_ = (idx_ >= L) ? nb + (size_t)(idx_ - L) * RS : cb + (size_t)idx_ * RS; \
        K0[u_] = *(const f32x4*)rp_; K1[u_] = *(const f32x4*)(rp_ + 4); V0[u_] = *(const f32x4*)(rp_ + VO); V1[u_] = *(const f32x4*)(rp_ + VO + 4); } } while (0)
#define DEC_COMP(K0, K1, V0, V1, J0) do { _Pragma("unroll") for (int u_ = 0; u_ < 4; ++u_) { \
        float s_ = qv[0] * K0[u_].x + qv[1] * K0[u_].y + qv[2] * K0[u_].z + qv[3] * K0[u_].w + qv[4] * K1[u_].x + qv[5] * K1[u_].y + qv[6] * K1[u_].z + qv[7] * K1[u_].w; \
        s_ = red8(s_); const float p_ = fexp2(s_ + tb[(J0) + u_]); l += p_; \
        acc[0] += p_ * V0[u_].x; acc[1] += p_ * V0[u_].y; acc[2] += p_ * V0[u_].z; acc[3] += p_ * V0[u_].w; acc[4] += p_ * V1[u_].x; acc[5] += p_ * V1[u_].y; acc[6] += p_ * V1[u_].z; acc[7] += p_ * V1[u_].w; } } while (0)
    DEC_LOAD(ak0, ak1, av0, av1, 0);
    for (int j0 = 0; j0 < 128; j0 += 8) {
        DEC_LOAD(bk0, bk1, bv0, bv1, j0 + 4);
        DEC_COMP(ak0, ak1, av0, av1, j0);
        if (j0 + 8 < 128) DEC_LOAD(ak0, ak1, av0, av1, j0 + 8);
        DEC_COMP(bk0, bk1, bv0, bv1, j0 + 4);
    }
#undef DEC_LOAD
#undef DEC_COMP
    if (IS_A) {
        const float li = 1.0f / (l + fexp2(F.snk[hd] * LOG2E - c.mref2));
        const u32x4 g = *(const u32x4*)(F.Gt + (size_t)row * GP + hd * 64 + sub * 8);
        u32x4 w; w.x = cvtpk(acc[0] * li * bflo(g.x), acc[1] * li * bfhi(g.x)); w.y = cvtpk(acc[2] * li * bflo(g.y), acc[3] * li * bfhi(g.y));
        w.z = cvtpk(acc[4] * li * bflo(g.z), acc[5] * li * bfhi(g.z)); w.w = cvtpk(acc[6] * li * bflo(g.w), acc[7] * li * bfhi(g.w));
        *(u32x4*)(F.AB + (size_t)row * DM + hd * 64 + sub * 8) = w;
    } else {
        u32x4 w; w.x = cvtpk(acc[0], acc[1]); w.y = cvtpk(acc[2], acc[3]); w.z = cvtpk(acc[4], acc[5]); w.w = cvtpk(acc[6], acc[7]);
        *(u32x4*)(F.OG + ((size_t)(grp - 1) * MR + row) * OGP + hd * 64 + sub * 8) = w;
        if (sub == 0) F.LG[((size_t)(grp - 1) * MR + row) * 8 + hd] = l;
    }
}

__device__ __forceinline__ void p2_setup(Frame& F) {
    LAS float* tab = (LAS float*)(F.lds + AT_TAB);
    LAS float* red = (LAS float*)(F.lds + AT_RED);
    volatile LAS unsigned* qctr = (volatile LAS unsigned*)(F.lds + AT_RED + 128);
    {
        int tid_ = F.tid; asm volatile("" : "+v"(tid_));
        float bm = fmaxf(F.relb[tid_], F.relb[tid_ + 512]);
        if (tid_ < 8) bm = fmaxf(bm, F.snk[tid_]);
        float gm = 0.f;
        if (tid_ < 64) gm = fabsf(F.qga[tid_] * F.kga[tid_]);
        else if (tid_ < 256) gm = fabsf(F.qgb[tid_ - 64] * F.kgb[tid_ - 64]);
        bm = wave_max(bm); gm = wave_max(gm);
        if (F.lane == 0) { red[F.wave] = bm; red[8 + F.wave] = gm; }
        if (F.tid == 0) { qctr[0] = 0u; qctr[1] = 0u; }
    }
    __syncthreads();
    float mref2;
    { float bm = red[0], gm = red[8];
#pragma unroll
      for (int w = 1; w < 8; ++w) { bm = fmaxf(bm, red[w]); gm = fmaxf(gm, red[8 + w]); }
      mref2 = (8.f * gm + bm) * LOG2E; }
    int tid2_ = F.tid; asm volatile("" : "+v"(tid2_));
    for (int idx = tid2_; idx < 32 * 192; idx += NTHR) {
        const int tb = idx / 192, e = idx % 192, j = e - 32, grp = tb >> 3, h = tb & 7;
        const int d = (grp <= 1) ? 1 : (grp == 2 ? 4 : 16), col = (grp == 0) ? h : 8 + (grp - 1) * 8 + h;
        float v = NEGBIG;
        if (j >= 0 && j <= 127) v = F.relb[t5_bucket(j * d) * 32 + col] * LOG2E - mref2;
        tab[idx] = v;
    }
    __syncthreads();
    if (F.tid == 0) red[16] = mref2;
    __syncthreads();
}
__device__ __forceinline__ void p2_setup_nosync(Frame& F, const int w0, const int nw) {
    LAS float* tab = (LAS float*)(F.lds + AT_TAB);
    LAS float* red = (LAS float*)(F.lds + AT_RED);
    volatile LAS unsigned* qctr = (volatile LAS unsigned*)(F.lds + AT_RED + 128);
    int ln = F.lane; asm volatile("" : "+v"(ln));
    float bm = -3.0e38f, gm = 0.f;
#pragma unroll
    for (int i = 0; i < 16; ++i) bm = fmaxf(bm, F.relb[ln + 64 * i]);
    if (ln < 8) bm = fmaxf(bm, F.snk[ln]);
    gm = fabsf(F.qga[ln] * F.kga[ln]);
#pragma unroll
    for (int i = 0; i < 3; ++i) gm = fmaxf(gm, fabsf(F.qgb[ln + 64 * i] * F.kgb[ln + 64 * i]));
    bm = wave_max(bm); gm = wave_max(gm);
    const float mref2 = (8.f * gm + bm) * LOG2E;
    for (int idx = (F.wave - w0) * 64 + ln; idx < 32 * 192; idx += nw * 64) {
        const int tb = idx / 192, e = idx % 192, j = e - 32, grp = tb >> 3, h = tb & 7;
        const int d = (grp <= 1) ? 1 : (grp == 2 ? 4 : 16), col = (grp == 0) ? h : 8 + (grp - 1) * 8 + h;
        float v = NEGBIG;
        if (j >= 0 && j <= 127) v = F.relb[t5_bucket(j * d) * 32 + col] * LOG2E - mref2;
        tab[idx] = v;
    }
    if (F.wave == w0 && ln == 0) { red[16] = mref2; qctr[0] = 0u; qctr[1] = 0u; }
}
__device__ __forceinline__ void xcd_barrier_with_setup(const XcdBarrier& b, Frame& F) {
    asm volatile("s_waitcnt vmcnt(0)" ::: "memory");
    __syncthreads();
    if (threadIdx.x == 0) xcd_barrier_t0(b);
    else if (F.wave != 0) p2_setup_nosync(F, 1, 7);
    __syncthreads();
}
__device__ __forceinline__ void xcd_barrier_with_weights(const XcdBarrier& b, Frame& F) {
    asm volatile("s_waitcnt vmcnt(0)" ::: "memory");
    __syncthreads();
    if (threadIdx.x == 0) xcd_barrier_t0(b);
    else if (F.wave != 0) p0_items(F, P0_I_IN, P0_NITEMS, 1, 7);
    __syncthreads();
}
#define GRAB_JOB(ctr, job) do { unsigned j_ = 0; if (F.lane == 0) j_ = __hip_atomic_fetch_add((LAS unsigned*)(ctr), 1u, __ATOMIC_RELAXED, __HIP_MEMORY_SCOPE_WORKGROUP); \
        (job) = (unsigned)__builtin_amdgcn_readfirstlane((int)j_); } while (0)
#define P2_CTX() LAS float* tab = (LAS float*)(F.lds + AT_TAB); volatile LAS unsigned* qctr = (volatile LAS unsigned*)(F.lds + AT_RED + 128); const float mref2 = ((LAS float*)(F.lds + AT_RED))[16]; \
    AttnCtx c; c.tab = tab; c.vt = F.lds + AT_VT + F.wave * 8192; c.lx = (LAS float*)(F.lds + AT_LX + F.wave * 128); c.lane = F.lane; c.r32 = F.lane & 31; c.hi = F.lane >> 5; c.mref2 = mref2
__device__ __forceinline__ void p2_decode(Frame& F) {
    P2_CTX();
    constexpr int NPAIR = 256;
    const int npair = (F.blk < NPAIR) ? (NPAIR - 1 - F.blk) / F.G + 1 : 0, ndec = 8 * npair;
    unsigned job; GRAB_JOB(qctr, job);
    while ((int)job < REP_DEC * ndec) { const int jd = (int)job % ndec;
        const int pair = F.blk + F.G * (jd >> 3), k = jd & 7, n = pair & 127, half = pair >> 7, t = k & 3;
        dec_unit(c, F, (half == 0) ? ((k < 4) ? 3 : 0) : ((k < 4) ? 2 : 1), n, t);
        GRAB_JOB(qctr, job); }
}
__device__ __forceinline__ void p2_items(Frame& F) {
    P2_CTX(); (void)qctr;
    LAS unsigned char* accb = F.lds + AT_ACC; LAS float* Lb = (LAS float*)(F.lds + AT_LSPAN);
    for (int rep = 0; rep < REP_ITEM; ++rep)
    for (int sidx = F.blk; sidx < 256; sidx += F.G) {
        const int x = sidx & 7, k = sidx >> 3, w = F.wave, h = x;
        const int bB = k >> 3, sp = k & 7, T0 = sp * 512;
#pragma unroll 1
        for (int st = 0; st < 4; ++st) {
            const bool isA = (st == 0);
            const int g = st - 1, d = (st <= 1) ? 1 : (st == 2 ? 4 : 16), nsub = (st == 3) ? 1 : 2, nitem = (st == 3) ? 2 : 1;
            const LAS float* tb = tab + (st * 8 + h) * 192;
#pragma unroll 1
            for (int it = 0; it < nitem; ++it) {
                int b, cls, m0, arow0;
                if (isA) { b = k & 3; cls = 0; m0 = 64 * ((k >> 2) + 8 * w); arow0 = 0; }
                else { b = bB; int mrel; if (st == 1) { cls = 0; mrel = 64 * w; } else if (st == 2) { cls = w >> 1; mrel = 64 * (w & 1); } else { cls = w + 8 * it; mrel = 0; }
                       m0 = T0 / d + mrel; arow0 = cls + d * mrel; }
                const long tok0 = (long)b * SEQ + cls + (long)d * m0;
                const int kt0 = (m0 >= 128) ? 0 : 4 - (m0 >> 5);
                const unsigned char* qp = isA ? F.Q8 + tok0 * Q8P + h * 64 : F.Q8 + tok0 * Q8P + 512 + g * 512 + h * 64;
                const unsigned char* kvp = isA ? F.KVA8 + (tok0 - 128L) * KVAP + (h >> 2) * 128 : F.KVB8 + (tok0 - 128L * d) * KVBP + (g * 8 + h) * 128;
                attn_prompt_pair(isA, c, qp, d * Q8P, kvp, isA ? KVAP : d * KVBP, kt0, tb, isA ? fexp2(F.snk[h] * LOG2E - mref2) : 0.f,
                                 (bf16*)(F.AB8 + tok0 * 1024 + h * 64), 1024, F.G8 + tok0 * G8P + h * 64, G8P, accb, Lb, arow0, d, st == 1, nsub);
            }
            if (!isA) __syncthreads();
        }
        const int b = bB;
        {
            const int t = F.tid; const float li = __builtin_amdgcn_rcpf(Lb[t]);
            bf16* orow = F.OG + ((size_t)b * SEQ + T0 + t) * OGP + h * 64;
#pragma unroll
            for (int j = 0; j < 8; ++j) { const u32x4 a = *(const LAS u32x4*)(accb + t * 128 + ((j ^ (t & 7)) << 4));
                u32x4 o; o.x = cvtpk(bflo(a.x) * li, bfhi(a.x) * li); o.y = cvtpk(bflo(a.y) * li, bfhi(a.y) * li); o.z = cvtpk(bflo(a.z) * li, bfhi(a.z) * li); o.w = cvtpk(bflo(a.w) * li, bfhi(a.w) * li);
                *(u32x4*)(orow + 8 * j) = o; }
        }
        __syncthreads();
    }
}
#undef P2_CTX
#undef GRAB_JOB
__device__ __forceinline__ void p2b_combine(Frame& F) {
    const int gw = F.blk * NWAVES + F.wave, NGW = F.G * NWAVES, hd = F.lane >> 3;
    for (int r0 = gw; r0 < MR; r0 += 3 * NGW) {
        u32x4 w[3][3], g[3]; float lg[3][3];
#pragma unroll
        for (int u = 0; u < 3; ++u) { const int row = r0 + u * NGW; if (row < MR) {
#pragma unroll
            for (int q = 0; q < 3; ++q) { const bool on = (row >= NP) || (q == 0);
                lg[u][q] = on ? ((row >= NP) ? F.LG[((size_t)q * MR + row) * 8 + hd] : 1.f) : 0.f;
                w[u][q] = on ? *(const u32x4*)(F.OG + ((size_t)q * MR + row) * OGP + F.lane * 8) : (u32x4){0u, 0u, 0u, 0u}; }
            if (row < NP) { const u32x2 g8 = *(const u32x2*)(F.G8 + (size_t)row * G8P + 512 + F.lane * 8); g[u] = (u32x4){g8.x, g8.y, 0u, 0u}; }
            else g[u] = *(const u32x4*)(F.Gt + (size_t)row * GP + 512 + F.lane * 8); } }
#pragma unroll
        for (int u = 0; u < 3; ++u) { const int row = r0 + u * NGW; if (row < MR) {
            float acc[8];
#pragma unroll
            for (int e = 0; e < 8; ++e) acc[e] = 0.f;
#pragma unroll
            for (int q = 0; q < 3; ++q) { acc[0] += bflo(w[u][q].x); acc[1] += bfhi(w[u][q].x); acc[2] += bflo(w[u][q].y); acc[3] += bfhi(w[u][q].y); acc[4] += bflo(w[u][q].z); acc[5] += bfhi(w[u][q].z); acc[6] += bflo(w[u][q].w); acc[7] += bfhi(w[u][q].w); }
            const float li = __builtin_amdgcn_rcpf(lg[u][0] + lg[u][1] + lg[u][2]);
            if (row < NP) { float gf[8]; f8x8((u32x2){g[u].x, g[u].y}, gf); const float ls = li * (64.f / G8S);
                u32x2 o8; o8.x = pk4_fp8(acc[0] * ls * gf[0], acc[1] * ls * gf[1], acc[2] * ls * gf[2], acc[3] * ls * gf[3]);
                o8.y = pk4_fp8(acc[4] * ls * gf[4], acc[5] * ls * gf[5], acc[6] * ls * gf[6], acc[7] * ls * gf[7]);
                *(u32x2*)(F.AB8 + (size_t)row * 1024 + 512 + F.lane * 8) = o8; }
            else { u32x4 o; o.x = cvtpk(acc[0] * li * bflo(g[u].x), acc[1] * li * bfhi(g[u].x)); o.y = cvtpk(acc[2] * li * bflo(g[u].y), acc[3] * li * bfhi(g[u].y));
                o.z = cvtpk(acc[4] * li * bflo(g[u].z), acc[5] * li * bfhi(g[u].z)); o.w = cvtpk(acc[6] * li * bflo(g[u].w), acc[7] * li * bfhi(g[u].w));
                *(u32x4*)(F.AB + (size_t)row * DM + 512 + F.lane * 8) = o; } } }
    }
}

template <int KW>
__device__ __forceinline__ void small_mma(f32x16 (&acc)[2], const bf16* A, int lda, const bf16* Bt, int ldb, int lane) {
    const int r32 = lane & 31, hi = lane >> 5;
    const bf16* ap = A + (size_t)r32 * lda + 8 * hi; const bf16* bp0 = Bt + (size_t)r32 * ldb + 8 * hi; const bf16* bp1 = bp0 + (size_t)32 * ldb;
    bf16x8 af[KW / 16], b0[KW / 16], b1[KW / 16];
#pragma unroll
    for (int s = 0; s < KW / 16; ++s) { af[s] = *(const bf16x8*)(ap + 16 * s); b0[s] = *(const bf16x8*)(bp0 + 16 * s); b1[s] = *(const bf16x8*)(bp1 + 16 * s); }
#pragma unroll
    for (int s = 0; s < KW / 16; ++s) { acc[0] = __builtin_amdgcn_mfma_f32_32x32x16_bf16(af[s], b0[s], acc[0], 0, 0, 0); acc[1] = __builtin_amdgcn_mfma_f32_32x32x16_bf16(af[s], b1[s], acc[1], 0, 0, 0); }
}
__device__ __forceinline__ void p3_small(Frame& F) {
    LAS float* red = (LAS float*)F.lds;
    for (int piece = F.blk; piece < 256; piece += F.G) {
        const int row0 = NP + 32 * (piece >> 4), col0 = 64 * (piece & 15);
        f32x16 ya[2], yb[2];
#pragma unroll
        for (int r = 0; r < 16; ++r) { ya[0][r] = 0.f; ya[1][r] = 0.f; yb[0][r] = 0.f; yb[1][r] = 0.f; }
        small_mma<64>(ya, F.AB + (size_t)row0 * DM + 64 * F.wave, DM, F.WUP + (size_t)col0 * DM + 64 * F.wave, DM, F.lane);
        small_mma<64>(yb, F.AB + (size_t)row0 * DM + 512 + 64 * F.wave, DM, F.WUP + (size_t)col0 * DM + 512 + 64 * F.wave, DM, F.lane);
#pragma unroll
        for (int cb = 0; cb < 2; ++cb)
#pragma unroll
            for (int r = 0; r < 16; ++r) { red[(((F.wave * 2 + 0) * 2 + cb) * 16 + r) * 64 + F.lane] = ya[cb][r]; red[(((F.wave * 2 + 1) * 2 + cb) * 16 + r) * 64 + F.lane] = yb[cb][r]; }
        __syncthreads();
#pragma unroll
        for (int i = 0; i < 4; ++i) {
            const int e = F.tid + 512 * i, cbr = e >> 6, ln = e & 63, cb = cbr >> 4, r = cbr & 15;
            float sa = 0.f, sb = 0.f;
#pragma unroll
            for (int w = 0; w < 8; ++w) { sa += red[(((w * 2 + 0) * 2 + cb) * 16 + r) * 64 + ln]; sb += red[(((w * 2 + 1) * 2 + cb) * 16 + r) * 64 + ln]; }
            const int row = row0 + crow(r, ln >> 5), col = col0 + cb * 32 + (ln & 31);
            const float ga = bflo((unsigned)F.Gt[(size_t)row * GP + 1024 + col]), gb = bflo((unsigned)F.Gt[(size_t)row * GP + 2048 + col]);
            F.MG[(size_t)row * DM + col] = (bf16)(cvtpk(ga * sa + gb * sb, 0.f) & 0xffffu);
        }
        __syncthreads();
    }
}
__device__ __forceinline__ void p4_small(Frame& F) {
    LAS float* red = (LAS float*)F.lds;
    for (int piece = F.blk; piece < 256; piece += F.G) {
        const int row0 = NP + 32 * (piece >> 4), col0 = 64 * (piece & 15);
        f32x16 y[2];
#pragma unroll
        for (int r = 0; r < 16; ++r) { y[0][r] = 0.f; y[1][r] = 0.f; }
        small_mma<128>(y, F.MG + (size_t)row0 * DM + 128 * F.wave, DM, F.WOUT + (size_t)col0 * DM + 128 * F.wave, DM, F.lane);
#pragma unroll
        for (int cb = 0; cb < 2; ++cb)
#pragma unroll
            for (int r = 0; r < 16; ++r) red[((F.wave * 2 + cb) * 16 + r) * 64 + F.lane] = y[cb][r];
        __syncthreads();
#pragma unroll
        for (int i = 0; i < 4; ++i) {
            const int e = F.tid + 512 * i, cbr = e >> 6, ln = e & 63, cb = cbr >> 4, r = cbr & 15;
            float sa = 0.f;
#pragma unroll
            for (int w = 0; w < 8; ++w) sa += red[((w * 2 + cb) * 16 + r) * 64 + ln];
            const int row = row0 + crow(r, ln >> 5), col = col0 + cb * 32 + (ln & 31);
            F.out[(size_t)row * DM + col] = F.xs[(size_t)(row - NP) * DM + col] + sa;
        }
        __syncthreads();
    }
}

constexpr int N_PHASES = 6;
__global__ void __launch_bounds__(NTHR, 2) fwd_kernel(Args args) {
    extern __shared__ __attribute__((aligned(16))) unsigned char lds_raw[];
    Frame F;
    F.lds = (LAS unsigned char*)lds_raw;
    F.tid = threadIdx.x; F.lane = F.tid & 63; F.wave = __builtin_amdgcn_readfirstlane(F.tid >> 6); F.G = gridDim.x; F.blk = blockIdx.x;
    unsigned char* ws = args.ws;
    F.xp = args.in[0]; F.xs = args.in[1]; F.ca = args.in[2]; F.cb1 = args.in[3]; F.cb2 = args.in[4]; F.cb3 = args.in[5]; F.relb = args.in[6]; F.ng = args.in[7]; F.win = args.in[8];
    F.qga = args.in[9]; F.kga = args.in[10]; F.snk = args.in[11]; F.qgb = args.in[12]; F.kgb = args.in[13]; F.wua = args.in[14]; F.wub = args.in[15]; F.wout = args.in[16]; F.out = args.out;
    F.WIN = (bf16*)(ws + WS_WIN); F.WUP = (bf16*)(ws + WS_WUP); F.WOUT = (bf16*)(ws + WS_WOUT); F.HB = (bf16*)(ws + WS_HB); F.HB8 = ws + WS_HB8; F.WIN8 = ws + WS_WIN8; F.AB8 = ws + WS_AB8; F.MG8 = ws + WS_MG8; F.WUP8 = ws + WS_WUP8; F.WOUT8 = ws + WS_WOUT8; F.G8 = ws + WS_G8; F.KVB8 = ws + WS_KVB8; F.KVA8 = ws + WS_KVA8; F.Q8 = ws + WS_Q8; F.Q = (bf16*)(ws + WS_Q); F.KA = (bf16*)(ws + WS_KA); F.VA = (bf16*)(ws + WS_VA);
    F.KB = (bf16*)(ws + WS_KB); F.VB = (bf16*)(ws + WS_VB); F.Gt = (bf16*)(ws + WS_G); F.OG = (bf16*)(ws + WS_OG); F.LG = (float*)(ws + WS_LG); F.AB = (bf16*)(ws + WS_AB); F.T = (bf16*)(ws + WS_T); F.MG = (bf16*)(ws + WS_MG);
    for (int u = F.tid; u < (LDS_BYTES - LDSCTL_OFF) / 4; u += NTHR) ((LAS unsigned*)(F.lds + LDSCTL_OFF))[u] = 0u;
    __syncthreads();
    volatile LAS unsigned* MISC = (volatile LAS unsigned*)(F.lds + MISC_OFF);
    const int lo = args.ph_lo, hi = args.ph_hi;
    XcdBarrier bar; bar.bar = (unsigned*)(ws + WS_CTL) + CW_BAR; bar.x = 0; bar.st = nullptr;
    if (hi - lo > 1) bar = xcd_barrier_post((unsigned*)(ws + WS_CTL) + CW_BAR, MISC + 8);
#define IN(k) (lo <= (k) && (k) < hi)
#define BOTH(k) (IN(k) && IN((k) + 1))
    if (IN(0)) { for (int rep = 0; rep < REP_P0; ++rep) { p0_prologue(F); if (BOTH(0)) xcd_barrier_with_weights(bar, F); else p0_items(F, P0_I_IN, P0_NITEMS, 0, NWAVES); } }
    if (IN(1)) {
        EpiP1 E{F.Q, F.KA, F.VA, F.KB, F.VB, F.Gt, F.out, F.qga, F.kga, F.qgb, F.kgb, F.KVA8, F.KVB8};
        { SchedP1 S; S.init(F.G, F.blk, 0); S.A = (const char*)F.HB; S.B = (const char*)F.WIN; pg8::gemm_phase<EpiP1, SchedP1, true, true, false>(F.lds, DM, S, E); }
        { EpiP1F8 E8{F.Q, F.Gt, F.qga, F.qgb, F.G8, F.Q8, F.kga, F.kgb, F.KVA8, F.KVB8}; SchedP1 S; S.init(F.G, F.blk, 1); S.A = (const char*)F.HB8; S.B = (const char*)F.WIN8; pg8::gemm_phase<EpiP1F8, SchedP1, true, true, true>(F.lds, DM, S, E8); }
        if (BOTH(1)) xcd_barrier_with_setup(bar, F);
    }
    if (IN(2)) {
        const int par = (F.blk >> 3) & 1;
        EpiP1F8 E8{F.Q, F.Gt, F.qga, F.qgb, F.G8, F.Q8, F.kga, F.kgb, F.KVA8, F.KVB8}; SchedP1 S; S.init(F.G, F.blk, 2); S.A = (const char*)F.HB8; S.B = (const char*)F.WIN8;
        if (!BOTH(1)) p2_setup(F);
        p2_items(F);
        __syncthreads();
        if (par != 0) pg8::gemm_phase<EpiP1F8, SchedP1, true, true, true>(F.lds, DM, S, E8);
        p2_decode(F);
        __syncthreads();
        if (par == 0) pg8::gemm_phase<EpiP1F8, SchedP1, true, true, true>(F.lds, DM, S, E8);
        if (BOTH(2)) xcd_barrier(bar);
    }
    if (IN(3)) { for (int rep = 0; rep < REP_P2B; ++rep) { p2b_combine(F); if (BOTH(3)) xcd_barrier(bar); } }
    if (IN(4)) {
        for (int rep = 0; rep < REP_P3; ++rep) {
        if (rep == 0) p3_small(F);
        SchedP3 S; S.o.init(NP, DM, F.G, F.blk); S.A = F.AB8; S.B = F.WUP8; S.scw = 0x7A7A7A7A; S.sca = 0x79797979;
        EpiP3 E{F.G8, F.MG8};
        pg8::gemm_phase<EpiP3, SchedP3, true, true, true, true>(F.lds, DM, S, E);
        if (BOTH(4)) xcd_barrier(bar);
        }
    }
    if (IN(5)) {
        for (int rep = 0; rep < REP_P4; ++rep) {
        SchedP4 S; S.o.init(NP, DM, F.G, F.blk); S.A = F.MG8; S.B = F.WOUT8; S.scw = 0x7A7A7A7A; S.sca = 0x79797979;
        EpiP4 E{F.xp, F.xs, F.out};
        pg8::gemm_phase<EpiP4, SchedP4, true, false, true>(F.lds, DM, S, E);
        if (rep == 0) { __syncthreads(); p4_small(F); }
        if (rep + 1 < REP_P4) xcd_barrier(bar);
        }
    }
#undef IN
#undef BOTH
}

extern "C" void kernel_launch(void* const* d_in, const int* in_sizes, int n_in, void* d_out, int out_size, void* d_ws, size_t ws_size, hipStream_t stream) {
    static int grid = 0;
    if (grid == 0) {
        if (n_in != 17 || out_size != (int)OUT_END || ws_size < WS_END) { fprintf(stderr, "kernel_launch: unexpected shapes (n_in %d out %d ws %zu)\n", n_in, out_size, ws_size); grid = -1; return; }
        int dev = 0, cus = 0, per_cu = 0;
        if (hipGetDevice(&dev) != hipSuccess || hipDeviceGetAttribute(&cus, hipDeviceAttributeMultiprocessorCount, dev) != hipSuccess) { grid = -1; return; }
        if (hipFuncSetAttribute((const void*)fwd_kernel, hipFuncAttributeMaxDynamicSharedMemorySize, LDS_BYTES) != hipSuccess) { fprintf(stderr, "kernel_launch: hipFuncSetAttribute failed\n"); grid = -1; return; }
        if (hipOccupancyMaxActiveBlocksPerMultiprocessor(&per_cu, (const void*)fwd_kernel, NTHR, LDS_BYTES) != hipSuccess || per_cu < 1) { fprintf(stderr, "kernel_launch: occupancy query says %d\n", per_cu); }
        (void)hipGetLastError();
        grid = cus;
    }
    if (grid < 0) return;
    (void)hipMemsetAsync((char*)d_ws + WS_CTL, 0, CTL_ZERO_BYTES, stream);
    Args a{};
    for (int i = 0; i < 17; ++i) a.in[i] = (const float*)d_in[i];
    a.out = (float*)d_out; a.ws = (unsigned char*)d_ws;
#if MK_N_LAUNCHES == 1
#if PROBE_LO >= 0
    a.ph_lo = PROBE_LO; a.ph_hi = PROBE_HI;
    hipLaunchKernelGGL(fwd_kernel, dim3(grid), dim3(NTHR), LDS_BYTES, stream, a);
    (void)hipMemsetAsync((char*)d_ws + WS_CTL, 0, CTL_ZERO_BYTES, stream);
#endif
    a.ph_lo = 0; a.ph_hi = N_PHASES;
    hipLaunchKernelGGL(fwd_kernel, dim3(grid), dim3(NTHR), LDS_BYTES, stream, a);
#else
    for (int p = 0; p < N_PHASES; ++p) { a.ph_lo = p; a.ph_hi = p + 1; hipLaunchKernelGGL(fwd_kernel, dim3(grid), dim3(NTHR), LDS_BYTES, stream, a); }
#endif
}
```
